# Optimizing an MI355X kernel written in HIP

```python
import jax, jax.numpy as jnp
from jax import lax
import numpy as np

D_MODEL = 1024
BATCH = 32
SEQ = 2048
DEPTH = 4

CHUNK = 64
Q_BLOCK = 128
HEAD_DIM = 64
N_BRANCH = 4
BRANCH_W = 256
NEG_INF = -1e30
A_HEADS = 4
A_W = A_HEADS * HEAD_DIM
B_HEADS = 4
B_W = B_HEADS * HEAD_DIM
C_HEADS = 4
C_Q_RANK = 256
C_KV_RANK = 128
C_NOPE = 64
C_ROPE = 32
C_V = 64
C_QK = C_NOPE + C_ROPE
ROPE_BASE = 10000.0
D_HEADS = 4
D_W = D_HEADS * HEAD_DIM
D_LEFT_CHUNKS = 8
D_BAND = (D_LEFT_CHUNKS + 1) * CHUNK
D_MAX_REL = 128
A_COLS = 3 * A_W + A_HEADS
B_COLS = 3 * B_W
C_COLS = C_Q_RANK + C_KV_RANK + C_ROPE
D_COLS = 3 * D_W
G_COLS = N_BRANCH * D_MODEL
IN_COLS = A_COLS + B_COLS + C_COLS + D_COLS + G_COLS
SPLITS = (A_COLS, A_COLS + B_COLS, A_COLS + B_COLS + C_COLS, A_COLS + B_COLS + C_COLS + D_COLS)
N_EXPERTS = 16
N_GROUPS = 4
EXPERTS_PER_GROUP = N_EXPERTS // N_GROUPS
TOP_K = 2
D_EXPERT = 256
D_SHARED = 256

kernel_name = "hybrid_chunk_causal_moe_trunk"


def rms_norm(x, g, eps=1e-6):
    x32 = x.astype(jnp.float32)
    y = x32 * lax.rsqrt(jnp.mean(x32 * x32, axis=-1, keepdims=True) + eps)
    return (y * g.astype(jnp.float32)).astype(x.dtype)


def rope_angles(positions):
    half = C_ROPE // 2
    inv_freq = jnp.power(ROPE_BASE, -jnp.arange(half, dtype=jnp.float32) / half)
    return positions.astype(jnp.float32)[:, :, None, None] * inv_freq


def apply_rope(t, ang):
    half = t.shape[-1] // 2
    cos, sin = jnp.cos(ang), jnp.sin(ang)
    t1, t2 = t[..., :half].astype(jnp.float32), t[..., half:].astype(jnp.float32)
    return jnp.concatenate([t1 * cos - t2 * sin, t1 * sin + t2 * cos], axis=-1).astype(t.dtype)


def swept_attention(q, k, v, weights_fn):
    B, S, H, _ = q.shape
    d_v = v.shape[-1]
    outs = []
    for blk in range(S // Q_BLOCK):
        q0, end = blk * Q_BLOCK, (blk + 1) * Q_BLOCK
        s = jnp.einsum('bqhd,bkhd->bhqk', q[:, q0:end], k[:, :end]).astype(jnp.float32)
        t_idx = jnp.arange(q0, end)[:, None]
        s_idx = jnp.arange(end)[None, :]
        w = weights_fn(s, t_idx, s_idx, q0, end)
        outs.append(jnp.einsum('bhqk,bkhd->bqhd', w.astype(v.dtype), v[:, :end]))
    return jnp.concatenate(outs, axis=1).reshape(B, S, H * d_v)


def chunk_band_attention(q, k, v, rel_bias):
    B, S, H, d = q.shape
    n = S // CHUNK
    left = D_LEFT_CHUNKS * CHUNK

    def band(t):
        tp = jnp.pad(t, ((0, 0), (left, 0), (0, 0), (0, 0))).reshape(B, n + D_LEFT_CHUNKS, CHUNK, H, d)
        return jnp.concatenate([tp[:, i:i + n] for i in range(D_LEFT_CHUNKS + 1)], axis=2)

    kb, vb = band(k), band(v)
    qc = q.reshape(B, n, CHUNK, H, d)
    s = jnp.einsum('bnqhd,bnkhd->bnhqk', qc, kb).astype(jnp.float32) * d ** -0.5
    dist = jnp.arange(CHUNK)[:, None] + left - jnp.arange(D_BAND)[None, :]
    bias = rel_bias[:, jnp.clip(dist, -D_MAX_REL, D_MAX_REL) + D_MAX_REL].astype(jnp.float32)
    key_pos = jnp.arange(n)[:, None] * CHUNK - left + jnp.arange(D_BAND)[None, :]
    valid = (key_pos >= 0)[None, :, None, None, :]
    w = jax.nn.softmax(jnp.where(valid, s + bias, NEG_INF), axis=-1)
    o = jnp.einsum('bnhqk,bnkhd->bnqhd', w.astype(v.dtype), vb)
    return o.reshape(B, S, H * d)


def token_mixers(h, positions, w_in, fox_forget_b, fox_q_g, fox_k_g, mla_cq_g, mla_ckv_g,
                 mla_w_uq, mla_w_ukv, mla_q_g, mla_k_g, chunk_q_g, chunk_k_g, chunk_rel_bias,
                 w_branch, w_out):
    B, S, _ = h.shape
    proj = h @ w_in
    pa, pb, pc, pd, pg = jnp.split(proj, SPLITS, axis=-1)

    def heads(t, n_heads):
        return t.reshape(B, S, n_heads, -1)

    qa, ka, va, fa = jnp.split(pa, [A_W, 2 * A_W, 3 * A_W], axis=-1)
    qa = rms_norm(heads(qa, A_HEADS), fox_q_g)
    ka = rms_norm(heads(ka, A_HEADS), fox_k_g)
    va = heads(va, A_HEADS)
    log_f = jax.nn.log_sigmoid(fa.astype(jnp.float32) + fox_forget_b.astype(jnp.float32))
    cum_f = jnp.transpose(jnp.cumsum(log_f, axis=1), (0, 2, 1))

    def fox_weights(s, t_idx, s_idx, q0, end):
        logits = s * HEAD_DIM ** -0.5 + cum_f[:, :, q0:end, None] - cum_f[:, :, None, :end]
        return jax.nn.softmax(jnp.where(s_idx <= t_idx, logits, NEG_INF), axis=-1)

    oa = swept_attention(qa, ka, va, fox_weights)

    qb, kb, vb = [heads(t, B_HEADS) for t in jnp.split(pb, [B_W, 2 * B_W], axis=-1)]

    def stick_weights(s, t_idx, s_idx, q0, end):
        z = s * HEAD_DIM ** -0.5
        strict = s_idx < t_idx
        log_keep = jnp.where(strict, jax.nn.log_sigmoid(-z), 0.0)
        after = lax.cumsum(log_keep, axis=3, reverse=True) - log_keep
        return jnp.where(strict, jnp.exp(jax.nn.log_sigmoid(z) + after), 0.0)

    ob = swept_attention(qb, kb, vb, stick_weights)

    cq, ckv, kr = jnp.split(pc, [C_Q_RANK, C_Q_RANK + C_KV_RANK], axis=-1)
    q_c = heads(rms_norm(cq, mla_cq_g) @ mla_w_uq, C_HEADS)
    kv_c = heads(rms_norm(ckv, mla_ckv_g) @ mla_w_ukv, C_HEADS)
    ang = rope_angles(positions)
    q_c = jnp.concatenate([q_c[..., :C_NOPE], apply_rope(q_c[..., C_NOPE:], ang)], axis=-1)
    k_rope = apply_rope(kr[:, :, None, :], ang)
    k_c = jnp.concatenate([kv_c[..., :C_NOPE], jnp.broadcast_to(k_rope, (B, S, C_HEADS, C_ROPE))], axis=-1)
    v_c = kv_c[..., C_NOPE:]
    q_c = rms_norm(q_c, mla_q_g)
    k_c = rms_norm(k_c, mla_k_g)

    def chunk_causal_weights(s, t_idx, s_idx, q0, end):
        logits = jnp.where(s_idx // CHUNK <= t_idx // CHUNK, s * C_QK ** -0.5, NEG_INF)
        return jax.nn.softmax(logits, axis=-1)

    oc = swept_attention(q_c, k_c, v_c, chunk_causal_weights)

    qd, kd, vd = [heads(t, D_HEADS) for t in jnp.split(pd, [D_W, 2 * D_W], axis=-1)]
    od = chunk_band_attention(rms_norm(qd, chunk_q_g), rms_norm(kd, chunk_k_g), vd, chunk_rel_bias)

    gates = jax.nn.sigmoid(pg.astype(jnp.float32)).astype(h.dtype).reshape(B, S, N_BRANCH, D_MODEL)
    branches = (oa, ob, oc, od)
    merged = gates[:, :, 0] * (branches[0] @ w_branch[0])
    for i in range(1, N_BRANCH):
        merged = merged + gates[:, :, i] * (branches[i] @ w_branch[i])
    return merged @ w_out


def swiglu(h, w_gate, w_up, w_down):
    return (jax.nn.silu(h @ w_gate) * (h @ w_up)) @ w_down


def moe_ffn(h, router_w, router_b, w_gate, w_up, w_down, sh_gate, sh_up, sh_down):
    scores = jax.nn.sigmoid((h @ router_w).astype(jnp.float32))
    sel = (scores + router_b.astype(jnp.float32)).reshape(*scores.shape[:-1], N_GROUPS, EXPERTS_PER_GROUP)
    group_score = lax.top_k(sel, 2)[0].sum(-1)
    grp = jnp.argmax(group_score, axis=-1)
    in_group = jnp.take_along_axis(sel, grp[..., None, None], axis=-2)[..., 0, :]
    _, local = lax.top_k(in_group, TOP_K)
    idx = grp[..., None] * EXPERTS_PER_GROUP + local
    w = jnp.take_along_axis(scores, idx, axis=-1)
    w = w / jnp.sum(w, axis=-1, keepdims=True)
    combine = jnp.sum(jax.nn.one_hot(idx, N_EXPERTS, dtype=jnp.float32) * w[..., None], axis=-2).astype(h.dtype)
    out = swiglu(h, sh_gate, sh_up, sh_down)
    for e in range(N_EXPERTS):
        out = out + combine[..., e:e + 1] * swiglu(h, w_gate[e], w_up[e], w_down[e])
    return out


def setup_inputs(seed: int = 0) -> dict:
    key = jax.random.key(seed)
    ks = iter(jax.random.split(key, 40))
    f32 = jnp.float32
    L = DEPTH

    def nrm(shape, scale):
        return scale * jax.random.normal(next(ks), shape, f32)

    def gain(shape):
        return 1.0 + 0.05 * jax.random.normal(next(ks), shape, f32)

    x = jax.random.normal(next(ks), (BATCH, SEQ, D_MODEL), f32)
    c = jax.random.normal(next(ks), (BATCH, D_MODEL), f32)
    offsets = jax.random.randint(next(ks), (BATCH, 1), 0, 64, dtype=jnp.int32) * CHUNK
    positions = (offsets + jnp.arange(SEQ, dtype=jnp.int32)[None, :]).astype(jnp.int32)
    return {
        "x": x,
        "c": c,
        "positions": positions,
        "norm_mix_g": gain((L, D_MODEL)),
        "norm_ffn_g": gain((L, D_MODEL)),
        "w_ada": nrm((L, D_MODEL, 6 * D_MODEL), 0.5 * D_MODEL ** -0.5),
        "b_ada": nrm((L, 6 * D_MODEL), 0.01),
        "w_in": nrm((L, D_MODEL, IN_COLS), D_MODEL ** -0.5),
        "fox_forget_b": jax.random.uniform(next(ks), (L, A_HEADS), f32, minval=1.0, maxval=5.0),
        "fox_q_g": gain((L, HEAD_DIM)),
        "fox_k_g": gain((L, HEAD_DIM)),
        "mla_cq_g": gain((L, C_Q_RANK)),
        "mla_ckv_g": gain((L, C_KV_RANK)),
        "mla_w_uq": nrm((L, C_Q_RANK, C_HEADS * C_QK), C_Q_RANK ** -0.5),
        "mla_w_ukv": nrm((L, C_KV_RANK, C_HEADS * (C_NOPE + C_V)), C_KV_RANK ** -0.5),
        "mla_q_g": gain((L, C_QK)),
        "mla_k_g": gain((L, C_QK)),
        "chunk_q_g": gain((L, HEAD_DIM)),
        "chunk_k_g": gain((L, HEAD_DIM)),
        "chunk_rel_bias": nrm((L, D_HEADS, 2 * D_MAX_REL + 1), 0.5),
        "w_branch": nrm((L, N_BRANCH, BRANCH_W, D_MODEL), BRANCH_W ** -0.5),
        "w_out": nrm((L, D_MODEL, D_MODEL), D_MODEL ** -0.5),
        "router_w": nrm((D_MODEL, N_EXPERTS), D_MODEL ** -0.5),
        "router_b": nrm((N_EXPERTS,), 0.01),
        "exp_w_gate": nrm((L, N_EXPERTS, D_MODEL, D_EXPERT), D_MODEL ** -0.5),
        "exp_w_up": nrm((L, N_EXPERTS, D_MODEL, D_EXPERT), D_MODEL ** -0.5),
        "exp_w_down": nrm((L, N_EXPERTS, D_EXPERT, D_MODEL), D_EXPERT ** -0.5),
        "sh_w_gate": nrm((L, D_MODEL, D_SHARED), D_MODEL ** -0.5),
        "sh_w_up": nrm((L, D_MODEL, D_SHARED), D_MODEL ** -0.5),
        "sh_w_down": nrm((L, D_SHARED, D_MODEL), D_SHARED ** -0.5),
    }


def reference(x, c, positions, norm_mix_g, norm_ffn_g, w_ada, b_ada, w_in, fox_forget_b,
              fox_q_g, fox_k_g, mla_cq_g, mla_ckv_g, mla_w_uq, mla_w_ukv, mla_q_g, mla_k_g,
              chunk_q_g, chunk_k_g, chunk_rel_bias, w_branch, w_out, router_w, router_b,
              exp_w_gate, exp_w_up, exp_w_down, sh_w_gate, sh_w_up, sh_w_down):
    cond = jax.nn.silu(c)
    for l in range(DEPTH):
        mod = (cond @ w_ada[l] + b_ada[l])[:, None, :]
        sh_m, sc_m, g_m, sh_f, sc_f, g_f = jnp.split(mod, 6, axis=-1)
        h = rms_norm(x, norm_mix_g[l]) * (1.0 + sc_m) + sh_m
        x = x + g_m * token_mixers(h, positions, w_in[l], fox_forget_b[l], fox_q_g[l], fox_k_g[l],
                                   mla_cq_g[l], mla_ckv_g[l], mla_w_uq[l], mla_w_ukv[l], mla_q_g[l],
                                   mla_k_g[l], chunk_q_g[l], chunk_k_g[l], chunk_rel_bias[l],
                                   w_branch[l], w_out[l])
        h = rms_norm(x, norm_ffn_g[l]) * (1.0 + sc_f) + sh_f
        x = x + g_f * moe_ffn(h, router_w, router_b, exp_w_gate[l], exp_w_up[l], exp_w_down[l],
                              sh_w_gate[l], sh_w_up[l], sh_w_down[l])
    return x
```

```cpp
#include <hip/hip_runtime.h>
#include <cstdio>
#include <cstdint>

#define GAS __attribute__((address_space(1)))
#define LAS __attribute__((address_space(3)))
typedef unsigned short bf16;
typedef unsigned v4u __attribute__((ext_vector_type(4)));
typedef unsigned v2u __attribute__((ext_vector_type(2)));
typedef float f32x2 __attribute__((ext_vector_type(2)));
typedef float f32x4 __attribute__((ext_vector_type(4)));
typedef float f32x16 __attribute__((ext_vector_type(16)));
typedef short bf16x8 __attribute__((ext_vector_type(8)));
typedef short s16x4 __attribute__((ext_vector_type(4)));
typedef GAS unsigned gu32;
#define RLX_AGENT __ATOMIC_RELAXED, __HIP_MEMORY_SCOPE_AGENT
#define DI __device__ __forceinline__

DI unsigned cvt_pk_bf16(float lo, float hi) { unsigned r; asm volatile("v_cvt_pk_bf16_f32 %0, %1, %2" : "=v"(r) : "v"(lo), "v"(hi)); return r; }
DI float bf_lo(unsigned u) { return __uint_as_float(u << 16); }
DI float bf_hi(unsigned u) { return __uint_as_float(u & 0xffff0000u); }
DI float bf2f(bf16 b) { return __uint_as_float(((unsigned)b) << 16); }
DI float fast_exp2(float x) { return __builtin_amdgcn_exp2f(x); }
DI float fast_log2(float x) { return __builtin_amdgcn_logf(x); }
DI float fast_rcp(float x) { return __builtin_amdgcn_rcpf(x); }
DI float sigmoid_f(float v) { return fast_rcp(1.0f + fast_exp2(-1.4426950408889634f * v)); }
DI float wave_sum(float v) {
#pragma unroll
    for (int o = 1; o < 64; o <<= 1) v += __shfl_xor(v, o);
    return v;
}

namespace pg8 {
#define PG8_LAS __attribute__((address_space(3)))
typedef unsigned short bf16_t;
constexpr int BM = 256, BK = 64, HALF = 128, HTB = HALF * BK * 2, STAGE_BYTES = 8 * HTB;

__host__ __device__ __forceinline__ int lds_byte(int r, int c) { const int st = (r >> 4) * 2 + (c >> 5), rr = r & 15, cc = c & 31, ob = rr * 64 + cc * 2; return st * 1024 + (ob ^ (((ob >> 9) & 1) << 5)); }
__host__ __device__ __forceinline__ void stage_rc(int b, int& R, int& C) { const int st = b / 1024, sb = b % 1024, swz = sb ^ (((sb >> 9) & 1) << 5); R = (st >> 1) * 16 + swz / 64; C = (st & 1) * 32 + (swz % 64) / 2; }
__host__ __device__ __forceinline__ int perm32(int rho) { const int n = rho >> 4, i = rho & 15; return 8 * (i >> 2) + 4 * n + (i & 3); }

struct Unit { int pm, pn, aux; const char* pa; const char* pb; };
__device__ __forceinline__ const char* uni_ptr(const char* p) { const unsigned long long v = (unsigned long long)p; const unsigned lo = __builtin_amdgcn_readfirstlane((unsigned)v), hi = __builtin_amdgcn_readfirstlane((unsigned)(v >> 32)); return (const char*)(((unsigned long long)hi << 32) | lo); }

typedef f32x4 Acc[2][2][4][2];

template <class Epi, class Sched, bool GATHER = false>
__device__ __forceinline__ void gemm_phase(PG8_LAS unsigned char* lds, const int tid, const int lda, const int ldb, const int K, const Sched& S, const Epi& E, const PG8_LAS int* rows = nullptr) {
    const int wid = __builtin_amdgcn_readfirstlane(tid >> 6), lane = tid & 63, wr = wid >> 2, wc = wid & 3, fr = lane & 15, fq = lane >> 4;
    int nt = K / BK; asm volatile("" : "+s"(nt));
    unsigned voffA[2], voffB[2];
#pragma unroll
    for (int i = 0; i < 2; ++i) { int R, C; stage_rc(tid * 16 + i * 8192, R, C); const int Rb = Epi::PERM ? ((R & ~31) + perm32(R & 31)) : R;
        voffA[i] = (unsigned)(R * lda + C) * 2u; voffB[i] = (unsigned)(Rb * ldb + C) * 2u; }
    unsigned cvA[2][2], nvA[2][2];
#define PG8_GOFFS(dst, uidx) do { _Pragma("unroll") for (int _h = 0; _h < 2; ++_h) _Pragma("unroll") for (int _i = 0; _i < 2; ++_i) { int R_, C_; stage_rc(tid * 16 + _i * 8192, R_, C_); \
        dst[_h][_i] = (unsigned)(rows[(uidx) * 256 + _h * 128 + R_] * lda + C_) * 2u; } } while (0)
#define PG8_STAGE_A(bufoff, gbase, half, offs) do { if constexpr (GATHER) { PG8_STAGE(bufoff, gbase, offs[half]); } else { PG8_STAGE(bufoff, (gbase) + ((half) ? hstepA : 0), voffA); } } while (0)
    const size_t kstep = (size_t)(BK * 2);
    const size_t hstepA = (size_t)HALF * lda * 2, hstepB = (size_t)HALF * ldb * 2;
    const unsigned ldsw = (unsigned)wid * 1024u;
    const int aoff = lds_byte(wr * 64 + fr, fq * 8), boff = lds_byte(wc * 32 + fr, fq * 8);
#define PG8_SA(b, h) (((b) * 2 + (h)) * HTB)
#define PG8_SB(b, h) ((4 + (b) * 2 + (h)) * HTB)
#define PG8_STAGE(bufoff, gbase, voff) do { _Pragma("unroll") for (int _i = 0; _i < 2; ++_i) \
        __builtin_amdgcn_global_load_lds((const unsigned*)((const char*)(gbase) + (voff)[_i]), (PG8_LAS unsigned*)(lds + (bufoff) + ldsw + _i * 8192), 16, 0, 0); } while (0)
#define PG8_LDA(dst, b, h) do { _Pragma("unroll") for (int m = 0; m < 4; ++m) _Pragma("unroll") for (int k = 0; k < 2; ++k) dst[m][k] = *(const PG8_LAS bf16x8*)(lds + PG8_SA(b, h) + aoff + m * 2048 + k * 1024); } while (0)
#define PG8_LDB(dst, b, h) do { _Pragma("unroll") for (int n = 0; n < 2; ++n) _Pragma("unroll") for (int k = 0; k < 2; ++k) dst[n][k] = *(const PG8_LAS bf16x8*)(lds + PG8_SB(b, h) + boff + n * 2048 + k * 1024); } while (0)
#define PG8_MMA(ai, bj, At, Bt) do { __builtin_amdgcn_s_setprio(1); _Pragma("unroll") for (int m = 0; m < 4; ++m) _Pragma("unroll") for (int n = 0; n < 2; ++n) _Pragma("unroll") for (int k = 0; k < 2; ++k) \
        acc[ai][bj][m][n] = __builtin_amdgcn_mfma_f32_16x16x32_bf16(Bt[n][k], At[m][k], acc[ai][bj][m][n], 0, 0, 0); __builtin_amdgcn_s_setprio(0); } while (0)
#define PG8_WAIT_V(n) asm volatile("s_waitcnt vmcnt(" #n ")" ::: "memory")
#define PG8_WAIT_L(n) asm volatile("s_waitcnt lgkmcnt(" #n ")" ::: "memory")
#define PG8_BAR __builtin_amdgcn_s_barrier()
#define PG8_SCHED __builtin_amdgcn_sched_barrier(0)
    Unit cur, nxt; int ui = 0;
    if (!S.next(0, cur)) return;
    Acc acc;
#pragma unroll
    for (int a = 0; a < 2; ++a)
#pragma unroll
        for (int b = 0; b < 2; ++b)
#pragma unroll
            for (int m = 0; m < 4; ++m)
#pragma unroll
                for (int n = 0; n < 2; ++n) acc[a][b][m][n] = (f32x4){0.f, 0.f, 0.f, 0.f};
    bf16x8 At[4][2], B0[2][2], B1[2][2];
    const char* cA = cur.pa; const char* cB = cur.pb;
    if constexpr (GATHER) { PG8_GOFFS(cvA, 0); }
    PG8_STAGE(PG8_SB(0, 0), cB, voffB); PG8_STAGE(PG8_SB(0, 1), cB + hstepB, voffB); PG8_STAGE_A(PG8_SA(0, 0), cA, 0, cvA); PG8_STAGE_A(PG8_SA(0, 1), cA, 1, cvA);
    if (wr == 1) PG8_BAR;
    PG8_WAIT_V(2); PG8_BAR;
    PG8_STAGE(PG8_SB(1, 0), cB + kstep, voffB); PG8_STAGE_A(PG8_SA(1, 0), cA + kstep, 0, cvA); PG8_STAGE(PG8_SB(1, 1), cB + hstepB + kstep, voffB);
    PG8_WAIT_V(6); PG8_BAR;
    for (;;) {
        const bool has_next = S.next(ui + 1, nxt);
        const char* nA = has_next ? nxt.pa : cA; const char* nB = has_next ? nxt.pb : cB;
        if constexpr (GATHER) { if (has_next) { PG8_GOFFS(nvA, ui + 1); } else { _Pragma("unroll") for (int _h = 0; _h < 2; ++_h) _Pragma("unroll") for (int _i = 0; _i < 2; ++_i) nvA[_h][_i] = cvA[_h][_i]; } }
#pragma nounroll
        for (int t = 0; t < nt; t += 2) {
            const bool last = (t == nt - 2);
            const char* a1 = cA + (size_t)(t + 1) * kstep;
            const char* a2 = last ? nA : cA + (size_t)(t + 2) * kstep; const char* b2 = last ? nB : cB + (size_t)(t + 2) * kstep;
            const char* a3 = a2 + kstep; const char* b3 = b2 + kstep;
            PG8_LDB(B0, 0, 0); PG8_LDB(B1, 0, 1); PG8_SCHED; PG8_LDA(At, 0, 0); PG8_STAGE_A(PG8_SA(1, 1), a1, 1, cvA);
            PG8_WAIT_V(8); PG8_WAIT_L(0); PG8_BAR; PG8_MMA(0, 0, At, B0); PG8_MMA(0, 1, At, B1); PG8_BAR; PG8_SCHED;
            PG8_LDA(At, 0, 1); PG8_STAGE(PG8_SB(0, 0), b2, voffB); PG8_STAGE(PG8_SB(0, 1), b2 + hstepB, voffB); if (last) { PG8_STAGE_A(PG8_SA(0, 0), a2, 0, nvA); } else { PG8_STAGE_A(PG8_SA(0, 0), a2, 0, cvA); }
            PG8_WAIT_V(8); PG8_WAIT_L(0); PG8_BAR; PG8_MMA(1, 0, At, B0); PG8_MMA(1, 1, At, B1); PG8_BAR; PG8_SCHED;
            PG8_LDB(B0, 1, 0); PG8_LDB(B1, 1, 1); PG8_SCHED; PG8_LDA(At, 1, 0); if (last) { PG8_STAGE_A(PG8_SA(0, 1), a2, 1, nvA); } else { PG8_STAGE_A(PG8_SA(0, 1), a2, 1, cvA); }
            PG8_WAIT_V(8); PG8_WAIT_L(0); PG8_BAR; PG8_MMA(0, 0, At, B0); PG8_MMA(0, 1, At, B1); PG8_BAR; PG8_SCHED;
            PG8_LDA(At, 1, 1); PG8_STAGE(PG8_SB(1, 0), b3, voffB); PG8_STAGE(PG8_SB(1, 1), b3 + hstepB, voffB); if (last) { PG8_STAGE_A(PG8_SA(1, 0), a3, 0, nvA); } else { PG8_STAGE_A(PG8_SA(1, 0), a3, 0, cvA); }
            PG8_WAIT_V(8); PG8_WAIT_L(0); PG8_BAR; PG8_MMA(1, 0, At, B0); PG8_MMA(1, 1, At, B1); PG8_BAR; PG8_SCHED;
        }
        if (wr == 0) PG8_BAR;
        E(acc, cur, has_next, nxt, wr, wc, fr, fq);
        if (!has_next) break;
        if constexpr (!Epi::CHAIN) {
#pragma unroll
            for (int a = 0; a < 2; ++a)
#pragma unroll
                for (int b = 0; b < 2; ++b)
#pragma unroll
                    for (int m = 0; m < 4; ++m)
#pragma unroll
                        for (int n = 0; n < 2; ++n) acc[a][b][m][n] = (f32x4){0.f, 0.f, 0.f, 0.f};
        }
        cur = nxt; cA = nA; cB = nB; ++ui;
        if constexpr (GATHER) { _Pragma("unroll") for (int _h = 0; _h < 2; ++_h) _Pragma("unroll") for (int _i = 0; _i < 2; ++_i) cvA[_h][_i] = nvA[_h][_i]; }
        if (wr == 1) PG8_BAR;
    }
    PG8_WAIT_V(0);
    PG8_BAR;
#undef PG8_SA
#undef PG8_SB
#undef PG8_STAGE
#undef PG8_STAGE_A
#undef PG8_GOFFS
#undef PG8_LDA
#undef PG8_LDB
#undef PG8_MMA
#undef PG8_WAIT_V
#undef PG8_WAIT_L
#undef PG8_BAR
#undef PG8_SCHED
}
}

namespace g8 {
using pg8::lds_byte; using pg8::stage_rc; using pg8::perm32;
typedef int v4i_t __attribute__((ext_vector_type(4)));
typedef int v8i_t __attribute__((ext_vector_type(8)));
constexpr int HTB = 16384;
__device__ __forceinline__ void gate_gemm_fp8(LAS unsigned char* lds, const int tid, const int G, const int c, const unsigned char* A8, const unsigned char* B8, bf16* GT, const float scale, const int nMtiles, const int nheavy) {
    const int wid = __builtin_amdgcn_readfirstlane(tid >> 6), lane = tid & 63, wr = wid >> 2, wc = wid & 3, fr = lane & 15, fq = lane >> 4;
    constexpr int KB = 1024, NT = KB / 128;
    const bool deal79 = (G == 256 && nMtiles == 128 && nheavy == 128);
    const int gq = c >> 4;
    const int nun = deal79 ? (gq < 8 ? 7 : 9) : ((nMtiles * 16 > c) ? (nMtiles * 16 - c + G - 1) / G : 0);
    const int pm0 = deal79 ? (gq < 8 ? gq * 7 : 56 + (gq - 8) * 9) : 0;
    if (nun == 0) return;
    const int total = nun * NT;
    unsigned voffA, voffB;
    { int R, C; stage_rc(tid * 16, R, C); const int Rb = (R & ~31) + perm32(R & 31); voffA = (unsigned)(R * KB + 2 * C); voffB = (unsigned)(Rb * KB + 2 * C); }
    const unsigned ldsw = (unsigned)wid * 1024u;
    const int aoff = lds_byte(wr * 64 + fr, fq * 8), boff = lds_byte(wc * 32 + fr, fq * 8);
#define G8_DMA2(bufoff, gbase, o0) do { __builtin_amdgcn_global_load_lds((const unsigned*)((const char*)(gbase) + (o0)), (LAS unsigned*)(lds + (bufoff) + ldsw), 16, 0, 0); \
        __builtin_amdgcn_global_load_lds((const unsigned*)((const char*)(gbase) + ((o0) + 64u * KB)), (LAS unsigned*)(lds + (bufoff) + ldsw + 8192), 16, 0, 0); } while (0)
#define G8_ISSUE(s) do { const int u_ = (s) / NT, kt_ = (s) % NT, b_ = (s) & 1; const long L_ = (long)u_ * G + c; const int pm_ = deal79 ? pm0 + u_ : (int)(L_ >> 4), pn_ = deal79 ? (c & 15) : (int)(L_ & 15); \
        const unsigned char* pa_ = (const unsigned char*)pg8::uni_ptr((const char*)A8 + (size_t)pm_ * 256 * KB + kt_ * 128); const unsigned char* pb_ = (const unsigned char*)pg8::uni_ptr((const char*)B8 + (size_t)pn_ * 256 * KB + kt_ * 128); \
        G8_DMA2((b_ * 4 + 2) * HTB, pb_, voffB); G8_DMA2((b_ * 4 + 3) * HTB, pb_, voffB + 128u * KB); G8_DMA2((b_ * 4 + 0) * HTB, pa_, voffA); G8_DMA2((b_ * 4 + 1) * HTB, pa_, voffA + 128u * KB); } while (0)
#define G8_RD(off) (*(const LAS bf16x8*)(lds + (off)))
#define G8_CAT(x, y) __builtin_shufflevector(__builtin_bit_cast(v4i_t, (x)), __builtin_bit_cast(v4i_t, (y)), 0, 1, 2, 3, 4, 5, 6, 7)
#define G8_MMA(ai, A8f) do { __builtin_amdgcn_s_setprio(1); _Pragma("unroll") for (int m = 0; m < 4; ++m) _Pragma("unroll") for (int n = 0; n < 2; ++n) { \
        acc[ai][0][m][n] = __builtin_amdgcn_mfma_scale_f32_16x16x128_f8f6f4(B0f[n], A8f[m], acc[ai][0][m][n], 0, 0, 0, 0, 0, 0); \
        acc[ai][1][m][n] = __builtin_amdgcn_mfma_scale_f32_16x16x128_f8f6f4(B1f[n], A8f[m], acc[ai][1][m][n], 0, 0, 0, 0, 0, 0); } __builtin_amdgcn_s_setprio(0); } while (0)
    f32x4 acc[2][2][4][2];
#pragma unroll
    for (int a = 0; a < 2; ++a)
#pragma unroll
        for (int b = 0; b < 2; ++b)
#pragma unroll
            for (int m = 0; m < 4; ++m)
#pragma unroll
                for (int n = 0; n < 2; ++n) acc[a][b][m][n] = (f32x4){0.f, 0.f, 0.f, 0.f};
    G8_ISSUE(0);
    if (total > 1) G8_ISSUE(1);
#pragma nounroll
    for (int s = 0; s < total; ++s) {
        const int b = s & 1;
        if (s + 1 < total && (s % NT) != 0) asm volatile("s_waitcnt vmcnt(8)" ::: "memory"); else asm volatile("s_waitcnt vmcnt(0)" ::: "memory");
        __builtin_amdgcn_s_barrier();
        asm volatile("" ::: "memory");
        v8i_t A8f[4], A8g[4], B0f[2], B1f[2];
        { const int ab = (b * 4) * HTB + aoff, bb = (b * 4 + 2) * HTB + boff;
#pragma unroll
          for (int n = 0; n < 2; ++n) { B0f[n] = G8_CAT(G8_RD(bb + n * 2048), G8_RD(bb + n * 2048 + 1024)); B1f[n] = G8_CAT(G8_RD(bb + HTB + n * 2048), G8_RD(bb + HTB + n * 2048 + 1024)); }
#pragma unroll
          for (int m = 0; m < 4; ++m) { A8f[m] = G8_CAT(G8_RD(ab + m * 2048), G8_RD(ab + m * 2048 + 1024)); A8g[m] = G8_CAT(G8_RD(ab + HTB + m * 2048), G8_RD(ab + HTB + m * 2048 + 1024)); } }
        asm volatile("s_waitcnt lgkmcnt(0)" ::: "memory");
        __builtin_amdgcn_s_barrier();
        asm volatile("" ::: "memory");
        if (s + 2 < total) G8_ISSUE(s + 2);
        G8_MMA(0, A8f);
        G8_MMA(1, A8g);
        if ((s % NT) == NT - 1) {
            const int u_ = s / NT; const long L_ = (long)u_ * G + c; const int pm_ = __builtin_amdgcn_readfirstlane(deal79 ? pm0 + u_ : (int)(L_ >> 4)), pn_ = __builtin_amdgcn_readfirstlane(deal79 ? (c & 15) : (int)(L_ & 15));
            const int c4 = 64 * pn_ + 16 * wc + 4 * fq;
            const int pno = c4 >> 8, bjc = (c4 >> 7) & 1, wcc = (c4 >> 5) & 3, fqc = (c4 >> 3) & 3, half = (c4 >> 2) & 1;
            bf16* tp = GT + ((size_t)(pm_ * 4 + pno) * 65536) + (size_t)((wr * 4 + wcc) * 64 + fqc * 16 + fr) * 8 + half * 4;
            const size_t BR = (size_t)nMtiles * 4 * 65536;
#pragma unroll
            for (int ai = 0; ai < 2; ++ai)
#pragma unroll
                for (int m = 0; m < 4; ++m) {
                    f32x4 g[4];
#pragma unroll
                    for (int q = 0; q < 4; ++q) { const f32x4 z = acc[ai][q >> 1][m][q & 1] * scale; g[q] = (f32x4){sigmoid_f(z[0]), sigmoid_f(z[1]), sigmoid_f(z[2]), sigmoid_f(z[3])};
                        acc[ai][q >> 1][m][q & 1] = (f32x4){0.f, 0.f, 0.f, 0.f}; }
                    bf16* sp = tp + (size_t)(((ai * 4 + m) * 2 + bjc) * 512) * 8;
#pragma unroll
                    for (int q = 0; q < 4; ++q) { f32x4 r = g[q];
                        if (q < 3) {
#pragma unroll
                            for (int k = 0; k < 4; ++k) r[k] = g[q][k] * fast_rcp(fmaxf(g[q + 1][k], 1e-20f)); }
                        v2u w; w.x = cvt_pk_bf16(r[0], r[1]); w.y = cvt_pk_bf16(r[2], r[3]); *(v2u*)(sp + q * BR) = w; }
                }
        }
    }
    asm volatile("s_waitcnt vmcnt(0)" ::: "memory");
    __builtin_amdgcn_s_barrier();
#undef G8_DMA2
#undef G8_ISSUE
#undef G8_RD
#undef G8_CAT
#undef G8_MMA
}
}
#define XB_TMO      128
#define XB_XCNT(j)  (256  + 64 * (j))
#define XB_XSUB(j)  (1280 + 64 * (j))
#define XB_XGEN(j)  (2304 + 64 * (j))
#define XB_TOP      3328
#define XB_TOPGEN   3392
#define XCD_BAR_WORDS 3456
#define XB_SPIN_CAP (1u << 18)

__device__ __forceinline__ unsigned xb_ld(unsigned* p)              { return __hip_atomic_load(p, __ATOMIC_RELAXED, __HIP_MEMORY_SCOPE_AGENT); }
__device__ __forceinline__ unsigned xb_add(unsigned* p, unsigned v) { return __hip_atomic_fetch_add(p, v, __ATOMIC_RELAXED, __HIP_MEMORY_SCOPE_AGENT); }
__device__ __forceinline__ unsigned xb_xcc_id() { return (unsigned)__builtin_amdgcn_s_getreg((3 << 11) | 20) & 0xFu; }
#define XB_SPIN(cond, bar) do { unsigned _sp = 0; while (cond) { __builtin_amdgcn_s_sleep(1); \
    if ((++_sp & 255u) == 0u) { if (xb_ld(&(bar)[XB_TMO])) break; if (_sp > XB_SPIN_CAP) { atomicAdd(&(bar)[XB_TMO], 1u); break; } } } } while (0)

struct XcdBarrier {
    unsigned* bar; unsigned x;
    volatile LAS unsigned* st;
};

__device__ __forceinline__ XcdBarrier xcd_barrier_post(unsigned* bar, volatile LAS unsigned* st) {
    XcdBarrier b; b.bar = bar; b.x = xb_xcc_id(); b.st = st;
    if (threadIdx.x == 0) (void)xb_add(&bar[XB_XCNT(b.x)], 1u);
    return b;
}
__device__ __forceinline__ void xcd_barrier_complete(unsigned* bar, unsigned x, unsigned& nloc, unsigned& nx) {
    const unsigned G = gridDim.x * gridDim.y * gridDim.z;
    unsigned sum, cnt, mine, sp = 0u;
    for (;;) {
        sum = 0u; cnt = 0u; mine = 0u;
#pragma unroll
        for (unsigned j = 0; j < 16; ++j) { const unsigned c = xb_ld(&bar[XB_XCNT(j)]); sum += c; cnt += (c > 0u) ? 1u : 0u; mine = (j == x) ? c : mine; }
        if (sum == G) break;
        __builtin_amdgcn_s_sleep(1);
        if ((++sp & 255u) == 0u) { if (xb_ld(&bar[XB_TMO])) break; if (sp > XB_SPIN_CAP) { atomicAdd(&bar[XB_TMO], 1u); break; } }
    }
    nloc = mine > 0u ? mine : 1u; nx = cnt > 0u ? cnt : 1u;
}

__device__ __forceinline__ void xcd_barrier(const XcdBarrier& b) {
    asm volatile("s_waitcnt vmcnt(0)" ::: "memory");
    __syncthreads();
    if (threadIdx.x == 0) {
        unsigned* bar = b.bar;
        __builtin_amdgcn_s_waitcnt(0);
        unsigned nloc = b.st[0], nx = b.st[1];
        if (nloc == 0u) { xcd_barrier_complete(bar, b.x, nloc, nx); b.st[0] = nloc; b.st[1] = nx; }
        const unsigned old = xb_add(&bar[XB_XSUB(b.x)], 1u);
        const unsigned gen = old / nloc;
        if (old + 1u == (gen + 1u) * nloc) {
            __builtin_amdgcn_fence(__ATOMIC_RELEASE, "agent");
            asm volatile("s_waitcnt vmcnt(0)" ::: "memory");
            const unsigned og = xb_add(&bar[XB_TOP], 1u);
            const unsigned tg = og / nx;
            if (og + 1u == (tg + 1u) * nx) xb_add(&bar[XB_TOPGEN], 1u);
            else XB_SPIN(xb_ld(&bar[XB_TOPGEN]) == tg, bar);
            __builtin_amdgcn_fence(__ATOMIC_ACQUIRE, "agent");
            xb_add(&bar[XB_XGEN(b.x)], 1u);
            asm volatile("s_waitcnt vmcnt(0)" ::: "memory");
        } else {
            XB_SPIN(xb_ld(&bar[XB_XGEN(b.x)]) == gen, bar);
            __builtin_amdgcn_fence(__ATOMIC_ACQUIRE, "agent");
            asm volatile("s_waitcnt vmcnt(0)" ::: "memory");
        }
    }
    __syncthreads();
}

constexpr int NB = 32, S = 2048, D = 1024, NL = 4;
constexpr int NBC = 16;
constexpr int NCHUNK = NB / NBC;
constexpr int TC = NBC * S;
constexpr int NP = 6912;
constexpr int PS = 2816;
constexpr int IN_COLS = 6820;
constexpr int PA_Q = 0, PA_K = 256, PA_V = 512, PB_Q = 768, PB_K = 1024, PB_V = 1280, PD_Q = 1536, PD_K = 1792, PD_V = 2048;
constexpr int PC_CQ = 2304, PC_CKV = 2560, PC_KR = 2688, PC_FA = 2720, PG = 2816;
constexpr int NEXP = 16, NEXP1 = 17;
constexpr int RPAD = 2 * TC + 4096;
constexpr float LOG2E = 1.4426950408889634f;
constexpr float EPS = 1e-6f;

constexpr size_t MiB = 1u << 20, KiB = 1u << 10;
constexpr size_t WS_CTL = 0, CTL_ZERO_BYTES = 1 * MiB;
constexpr size_t WS_MOD = 1 * MiB;
constexpr size_t WS_TOKE = 4 * MiB;
constexpr size_t WS_TOKW = WS_TOKE + 256 * KiB;
constexpr size_t WS_TOKPOS = WS_TOKW + 256 * KiB;
constexpr size_t WS_CNT = WS_TOKPOS + 256 * KiB;
constexpr size_t WS_TILEEXP = WS_CNT + 32 * KiB;
constexpr size_t WS_LOGF = 5 * MiB;
constexpr size_t WS_ROPE = 6 * MiB;
constexpr size_t WS_LIST = 10 * MiB;
constexpr size_t WS_WIN = 12 * MiB;
constexpr size_t WS_WMLA = 66 * MiB;
constexpr size_t WS_WBR = 69 * MiB;
constexpr size_t WS_WOUT = 77 * MiB;
constexpr size_t WS_WGU = 85 * MiB;
constexpr size_t WS_WD = 153 * MiB;
constexpr size_t WS_H = 187 * MiB;
constexpr size_t WS_O = 251 * MiB;
constexpr size_t WS_MG = 315 * MiB;
constexpr size_t WS_QKVC = 379 * MiB;
constexpr size_t WS_QC = 443 * MiB;
constexpr size_t WS_KC = 467 * MiB;
constexpr size_t WS_PROJ = 491 * MiB;
constexpr size_t WS_GT = 667 * MiB;
constexpr size_t WS_HS = 491 * MiB;
constexpr size_t WS_HID = 627 * MiB;
constexpr size_t WS_YBUF = 677 * MiB;
constexpr size_t WS_XB = 923 * MiB;
constexpr size_t WS_H8 = 987 * MiB;
constexpr size_t WS_END = 1019 * MiB;
constexpr float WG8_SCALE = 64.0f;
static_assert(WS_PROJ + (size_t)TC * PS * 2 <= WS_GT && WS_GT + (size_t)4 * TC * 1024 * 2 <= WS_XB && WS_PROJ + (size_t)TC * PS * 2 <= WS_END && WS_HS + (size_t)RPAD * 1024 * 2 <= WS_HID && WS_HID + (size_t)(TC + RPAD) * 256 * 2 <= WS_YBUF && WS_YBUF + (size_t)RPAD * 1024 * 2 <= WS_XB, "ws map");
static_assert(WS_WIN + (size_t)NL * NP * 1024 * 2 <= WS_WMLA && WS_WGU + (size_t)NL * NEXP1 * 512 * 1024 * 2 <= WS_WD && WS_WD + (size_t)NL * NEXP1 * 1024 * 256 * 2 <= WS_H, "ws map 2");
constexpr int CW_TMO = 0, CW_BAR = 4096, CW_GCNT = 16384;
constexpr int NMT_WORD = 1000;

constexpr int RING_BYTES = 131072;
constexpr int MISC_OFF = RING_BYTES + 320;
constexpr int LDS_BYTES = 147456;
constexpr int NWAVES = 8, NTHREADS = 512;

struct Args {
    const float* in[30]; float* out; unsigned char* ws;
    int c_lo, c_hi, l_lo, l_hi, ph_lo, ph_hi, one, pad;
};

struct Frame {
    LAS unsigned char* lds;
    int tid, lane, wave, G, bx;
    unsigned char* ws;
};
constexpr int MOET_OFF = RING_BYTES + 1536;
constexpr int ROWS_OFF = RING_BYTES + 4096;
constexpr int PTAB_OFF = RING_BYTES + 1024;
DI const float* inp(const Frame& F, int k) {
    const unsigned long long v = ((volatile LAS unsigned long long*)(F.lds + PTAB_OFF))[k];
    const unsigned lo = __builtin_amdgcn_readfirstlane((unsigned)v), hi = __builtin_amdgcn_readfirstlane((unsigned)(v >> 32));
    return (const float*)(((unsigned long long)hi << 32) | lo);
}

struct MapIdent { int off; DI int operator()(int n) const { return off + n; } };
struct MapGate { int off; DI int operator()(int n) const { return (n >> 7) * 256 + off + (n & 127); } };
struct MapIn { DI int operator()(int s) const {
    if (s < 768) return s;
    if (s < 772) return PC_FA + (s - 768);
    if (s < 1540) return PB_Q + (s - 772);
    if (s < 1956) return PC_CQ + (s - 1540);
    if (s < 2724) return PD_Q + (s - 1956);
    return -1; } };

template <class Map> DI void tr_item(const float* W, int N, bf16* WT, int ldk, int koff, LAS float* scr, int k0, int n0, int lane, const Map map) {
    const int nn = n0 + (lane & 31);
    float tv[32];
#pragma unroll
    for (int i = 0; i < 32; ++i) { const int kk = 2 * i + (lane >> 5); tv[i] = (nn < N) ? W[(size_t)(k0 + kk) * N + nn] : 0.f; }
#pragma unroll
    for (int i = 0; i < 32; ++i) { const int kk = 2 * i + (lane >> 5); scr[kk * 33 + (lane & 31)] = tv[i]; }
    asm volatile("s_waitcnt lgkmcnt(0)" ::: "memory");
    const int c = lane & 7;
#pragma unroll
    for (int j = 0; j < 4; ++j) { const int nl = (lane >> 3) + 8 * j; const LAS float* s = scr + (8 * c) * 33 + nl;
        v4u o; o.x = cvt_pk_bf16(s[0 * 33], s[1 * 33]); o.y = cvt_pk_bf16(s[2 * 33], s[3 * 33]); o.z = cvt_pk_bf16(s[4 * 33], s[5 * 33]); o.w = cvt_pk_bf16(s[6 * 33], s[7 * 33]);
        const int dr = (n0 + nl < N) ? map(n0 + nl) : -1;
        if (dr >= 0) *(v4u*)(WT + (size_t)dr * ldk + koff + k0 + 8 * c) = o; }
    asm volatile("s_waitcnt lgkmcnt(0)" ::: "memory");
}

DI unsigned pk4_fp8(float a, float b, float c, float d) { int p = 0; p = __builtin_amdgcn_cvt_pk_fp8_f32(a, b, p, false); p = __builtin_amdgcn_cvt_pk_fp8_f32(c, d, p, true); return (unsigned)p; }
DI void tr_item8(const float* W, int N, unsigned char* WT8, int ldk, LAS float* scr, int k0, int n0, int nbase, int lane, float scale) {
    const int nn = n0 + (lane & 31);
    float tv[32];
#pragma unroll
    for (int i = 0; i < 32; ++i) { const int kk = 2 * i + (lane >> 5); tv[i] = (nn < N) ? W[(size_t)(k0 + kk) * N + nn] : 0.f; }
#pragma unroll
    for (int i = 0; i < 32; ++i) { const int kk = 2 * i + (lane >> 5); scr[kk * 33 + (lane & 31)] = tv[i] * scale; }
    asm volatile("s_waitcnt lgkmcnt(0)" ::: "memory");
    const int c = lane & 7;
#pragma unroll
    for (int j = 0; j < 4; ++j) { const int nl = (lane >> 3) + 8 * j; const LAS float* s = scr + (8 * c) * 33 + nl;
        v2u o; o.x = pk4_fp8(s[0 * 33], s[1 * 33], s[2 * 33], s[3 * 33]); o.y = pk4_fp8(s[4 * 33], s[5 * 33], s[6 * 33], s[7 * 33]);
        if (n0 + nl < N) { const int gi = n0 + nl - nbase, b = gi >> 10, cc = gi & 1023;
            const int row = (cc >> 6) * 256 + 128 * (b >> 1) + 32 * ((cc >> 4) & 3) + 8 * ((cc >> 2) & 3) + 4 * (b & 1) + (cc & 3);
            *(v2u*)(WT8 + (size_t)row * ldk + k0 + 8 * c) = o; } }
    asm volatile("s_waitcnt lgkmcnt(0)" ::: "memory");
}

constexpr int I_G8 = 16 * 128;
constexpr int I_IN = 16 * 214, I_UQ = 48, I_UKV = 32, I_BR = 512, I_OUT = 512, I_G = NEXP1 * 128, I_DN = NEXP1 * 128;
constexpr int NITEM_L = I_IN + I_UQ + I_UKV + I_BR + I_OUT + 2 * I_G + I_DN + I_G8;

DI void p0_prologue(const Frame& F, const Args& A) {
    unsigned char* ws = F.ws;
    {
        LAS float* condL = (LAS float*)F.lds;
        const float* c = inp(F, 1);
        for (int idx = F.tid; idx < NB * D; idx += NTHREADS) { const float v = c[idx]; const int b = idx >> 10, k = idx & 1023; condL[k * 32 + b] = v * sigmoid_f(v); }
        __syncthreads();
        const float* w_ada = inp(F, 5); const float* b_ada = inp(F, 6); float* MOD = (float*)(ws + WS_MOD);
        const int gw = F.bx * NWAVES + F.wave, NGW = F.G * NWAVES;
        for (int u = gw; u < NL * 384; u += NGW) {
            const int l = u / 384, j0 = (u % 384) * 16, col = F.lane & 15, ks = F.lane >> 4;
            float acc[32];
#pragma unroll
            for (int b = 0; b < 32; ++b) acc[b] = 0.f;
            const float* wp = w_ada + ((size_t)l * D + ks * 256) * 6144 + j0 + col;
#pragma unroll 16
            for (int k = 0; k < 256; ++k) {
                const float w = wp[(size_t)k * 6144];
                const LAS f32x4* cl = (const LAS f32x4*)(condL + (ks * 256 + k) * 32);
#pragma unroll
                for (int q = 0; q < 8; ++q) { const f32x4 cv = cl[q]; acc[4 * q] += w * cv.x; acc[4 * q + 1] += w * cv.y; acc[4 * q + 2] += w * cv.z; acc[4 * q + 3] += w * cv.w; }
            }
            const float bias = b_ada[l * 6144 + j0 + col];
#pragma unroll
            for (int b = 0; b < 32; ++b) { float v = acc[b]; v += __shfl_xor(v, 16); v += __shfl_xor(v, 32); if (ks == 0) MOD[((size_t)l * NB + b) * 6144 + j0 + col] = v + bias; }
        }
        __syncthreads();
    }
    {
        LAS float* scr = (LAS float*)(F.lds + F.wave * 16384);
        const int gw = F.bx * NWAVES + F.wave, NGW = F.G * NWAVES;
        bf16* WinT = (bf16*)(ws + WS_WIN); bf16* WmlaT = (bf16*)(ws + WS_WMLA); bf16* WbrT = (bf16*)(ws + WS_WBR); bf16* WoutT = (bf16*)(ws + WS_WOUT);
        bf16* WguT = (bf16*)(ws + WS_WGU); bf16* WdT = (bf16*)(ws + WS_WD);
        for (int it = gw; it < NL * NITEM_L; it += NGW) {
            const int l = it / NITEM_L; int r = it % NITEM_L;
            if (r < I_IN) { const int kb = r / 214, nb = r % 214; tr_item(inp(F, 7) + (size_t)l * D * IN_COLS, IN_COLS, WinT + (size_t)l * NP * 1024, 1024, 0, scr, 64 * kb, 32 * nb, F.lane, MapIn{}); continue; } r -= I_IN;
            if (r < I_UQ) { const int kb = r / 12, nb = r % 12; tr_item(inp(F, 13) + (size_t)l * 256 * 384, 384, WmlaT + (size_t)l * 1024 * 384, 384, 0, scr, 64 * kb, 32 * nb, F.lane, MapIdent{0}); continue; } r -= I_UQ;
            if (r < I_UKV) { const int kb = r / 16, nb = r % 16; tr_item(inp(F, 14) + (size_t)l * 128 * 512, 512, WmlaT + (size_t)l * 1024 * 384, 384, 256, scr, 64 * kb, 32 * nb, F.lane, MapIdent{384}); continue; } r -= I_UKV;
            if (r < I_BR) { const int b = r / 128, rr = r % 128, kb = rr / 32, nb = rr % 32; tr_item(inp(F, 20) + (size_t)(l * 4 + b) * 256 * 1024, 1024, WbrT + (size_t)(l * 4 + b) * 1024 * 256, 256, 0, scr, 64 * kb, 32 * nb, F.lane, MapIdent{0}); continue; } r -= I_BR;
            if (r < I_OUT) { const int kb = r / 32, nb = r % 32; tr_item(inp(F, 21) + (size_t)l * 1024 * 1024, 1024, WoutT + (size_t)l * 1024 * 1024, 1024, 0, scr, 64 * kb, 32 * nb, F.lane, MapIdent{0}); continue; } r -= I_OUT;
            if (r < I_G) { const int e = r / 128, rr = r % 128, kb = rr / 8, nb = rr % 8; const float* src = e < 16 ? inp(F, 24) + (size_t)(l * 16 + e) * 1024 * 256 : inp(F, 27) + (size_t)l * 1024 * 256;
                tr_item(src, 256, WguT + (size_t)(l * NEXP1 + e) * 512 * 1024, 1024, 0, scr, 64 * kb, 32 * nb, F.lane, MapGate{0}); continue; } r -= I_G;
            if (r < I_G) { const int e = r / 128, rr = r % 128, kb = rr / 8, nb = rr % 8; const float* src = e < 16 ? inp(F, 25) + (size_t)(l * 16 + e) * 1024 * 256 : inp(F, 28) + (size_t)l * 1024 * 256;
                tr_item(src, 256, WguT + (size_t)(l * NEXP1 + e) * 512 * 1024, 1024, 0, scr, 64 * kb, 32 * nb, F.lane, MapGate{128}); continue; } r -= I_G;
            if (r >= I_DN) { r -= I_DN; const int kb = r / 128, nb = r % 128;
                tr_item8(inp(F, 7) + (size_t)l * D * IN_COLS, IN_COLS, (unsigned char*)(WinT + ((size_t)l * NP + PG) * 1024), 1024, scr, 64 * kb, 2724 + 32 * nb, 2724, F.lane, WG8_SCALE); continue; }
            { const int e = r / 128, rr = r % 128, kb = rr / 32, nb = rr % 32; const float* src = e < 16 ? inp(F, 26) + (size_t)(l * 16 + e) * 256 * 1024 : inp(F, 29) + (size_t)l * 256 * 1024;
                tr_item(src, 1024, WdT + (size_t)(l * NEXP1 + e) * 1024 * 256, 256, 0, scr, 64 * kb, 32 * nb, F.lane, MapIdent{0}); }
        }
        const int gt = F.bx * NTHREADS + F.tid, NGT = F.G * NTHREADS;
        const v4u z = {0u, 0u, 0u, 0u};
        for (int p = gt; p < NL * 92 * 128; p += NGT) { const int l = p / (92 * 128), q = p % (92 * 128), row = 2724 + q / 128, kc = (q % 128) * 8; *(v4u*)(WinT + ((size_t)l * NP + row) * 1024 + kc) = z; }
        for (int p = gt; p < NL * 1024 * 48; p += NGT) { const int l = p / (1024 * 48), q = p % (1024 * 48), row = q / 48, kc = (q % 48) * 8;
            const bool zr = (row < 384 && kc >= 256) || (row >= 384 && row < 896 && kc < 256) || row >= 896;
            if (zr) *(v4u*)(WmlaT + ((size_t)l * 1024 + row) * 384 + kc) = z; }
    }
}

template <bool ROUTER>
DI void norm_phase(const Frame& F, const Args& A, const float* xs, const bf16* xb, int chunk, int layer) {
    unsigned char* ws = F.ws;
    bf16* H = (bf16*)(ws + WS_H);
    const float* gain = inp(F, ROUTER ? 4 : 3) + layer * D;
    const float* MOD = (const float*)(ws + WS_MOD) + (size_t)layer * NB * 6144;
    const int SH = ROUTER ? 3072 : 0, SC = ROUTER ? 4096 : 1024;
    LAS f32x4* RW = (LAS f32x4*)F.lds;
    LAS float* wscr = (LAS float*)(F.lds + 65536) + F.wave * 64;
    LAS int* cntL = (LAS int*)(F.lds + 65536 + 2048);
    LAS int* baseL = cntL + 16; LAS int* selL = cntL + 64;
    if (ROUTER) {
        const float* rw = inp(F, 22);
        for (int idx = F.tid; idx < 4 * 16 * 64; idx += NTHREADS) { const int ln = idx & 63, e = (idx >> 6) & 15, j = idx >> 10; const int col = 4 * ln + 256 * j;
            RW[idx] = (f32x4){rw[(col + 0) * 16 + e], rw[(col + 1) * 16 + e], rw[(col + 2) * 16 + e], rw[(col + 3) * 16 + e]}; }
        if (F.tid < 16) cntL[F.tid] = 0;
        __syncthreads();
    }
    for (int rb = F.bx; rb < TC / 128; rb += F.G) {
        const int r0 = rb * 128 + F.wave * 16;
        const int b = (chunk * TC + r0) / S;
        f32x4 gs[4], shv[4];
#pragma unroll
        for (int j = 0; j < 4; ++j) { const int col = 4 * F.lane + 256 * j; const f32x4 g = *(const f32x4*)(gain + col), sc = *(const f32x4*)(MOD + (size_t)b * 6144 + SC + col);
            gs[j] = g * (sc + 1.0f); shv[j] = *(const f32x4*)(MOD + (size_t)b * 6144 + SH + col); }
        for (int rq = 0; rq < 16; rq += 4) {
            f32x4 y[4][4];
#pragma unroll
            for (int rr = 0; rr < 4; ++rr) {
                const int row = r0 + rq + rr;
                float ss = 0.f;
                if (xs) { const f32x4* xr = (const f32x4*)(xs + (size_t)row * D) + F.lane;
#pragma unroll
                    for (int j = 0; j < 4; ++j) y[rr][j] = xr[64 * j]; }
                else { const v2u* xr = (const v2u*)(xb + (size_t)row * D) + F.lane;
#pragma unroll
                    for (int j = 0; j < 4; ++j) { const v2u r = xr[64 * j]; y[rr][j] = (f32x4){bf_lo(r.x), bf_hi(r.x), bf_lo(r.y), bf_hi(r.y)}; } }
#pragma unroll
                for (int j = 0; j < 4; ++j) { ss += (y[rr][j].x * y[rr][j].x + y[rr][j].y * y[rr][j].y) + (y[rr][j].z * y[rr][j].z + y[rr][j].w * y[rr][j].w); }
                const float rs = 1.0f / sqrtf(wave_sum(ss) * (1.0f / D) + EPS);
                unsigned long long* o8 = (unsigned long long*)(H + (size_t)row * D) + F.lane;
#pragma unroll
                for (int j = 0; j < 4; ++j) { y[rr][j] = y[rr][j] * rs * gs[j] + shv[j];
                    o8[64 * j] = (unsigned long long)cvt_pk_bf16(y[rr][j].x, y[rr][j].y) | ((unsigned long long)cvt_pk_bf16(y[rr][j].z, y[rr][j].w) << 32);
                    if (!ROUTER) { const f32x4 c = __builtin_elementwise_min(__builtin_elementwise_max(y[rr][j], (f32x4){-448.f, -448.f, -448.f, -448.f}), (f32x4){448.f, 448.f, 448.f, 448.f});
                        *(unsigned*)(ws + WS_H8 + (size_t)row * D + 4 * F.lane + 256 * j) = pk4_fp8(c.x, c.y, c.z, c.w); } }
            }
            if (ROUTER) {
                float v[64];
#pragma unroll
                for (int i = 0; i < 64; ++i) v[i] = 0.f;
#pragma unroll
                for (int j = 0; j < 4; ++j)
#pragma unroll
                    for (int e = 0; e < 16; ++e) { const f32x4 w = RW[(j * 16 + e) * 64 + F.lane];
#pragma unroll
                        for (int rr = 0; rr < 4; ++rr) v[rr * 16 + e] += (y[rr][j].x * w.x + y[rr][j].y * w.y) + (y[rr][j].z * w.z + y[rr][j].w * w.w); }
#pragma unroll
                for (int d = 32; d >= 1; d >>= 1) {
                    const bool up = (F.lane & d) != 0;
#pragma unroll
                    for (int k = 0; k < d; ++k) { const float send = up ? v[k] : v[k + d]; const float keep = up ? v[k + d] : v[k]; v[k] = keep + __shfl_xor(send, d); }
                }
                wscr[F.lane] = v[0];
                __builtin_amdgcn_wave_barrier();
                asm volatile("s_waitcnt lgkmcnt(0)" ::: "memory");
                float lg[16];
                { const LAS f32x4* p = (const LAS f32x4*)(wscr + (F.lane >> 4) * 16);
#pragma unroll
                  for (int q = 0; q < 4; ++q) { const f32x4 t = p[q]; lg[4 * q] = t.x; lg[4 * q + 1] = t.y; lg[4 * q + 2] = t.z; lg[4 * q + 3] = t.w; } }
                __builtin_amdgcn_wave_barrier();
                const float* rbias = inp(F, 23);
                float sc[16], sel[16];
#pragma unroll
                for (int e = 0; e < 16; ++e) { sc[e] = 1.0f / (1.0f + expf(-lg[e])); sel[e] = sc[e] + rbias[e]; }
                float gsc[4];
#pragma unroll
                for (int g = 0; g < 4; ++g) { const float a0 = sel[4 * g], a1 = sel[4 * g + 1], a2 = sel[4 * g + 2], a3 = sel[4 * g + 3];
                    const float h1 = fmaxf(a0, a1), l1 = fminf(a0, a1), h2 = fmaxf(a2, a3), l2 = fminf(a2, a3);
                    gsc[g] = fmaxf(h1, h2) + fmaxf(fminf(h1, h2), fmaxf(l1, l2)); }
                int grp = 0; float best = gsc[0];
#pragma unroll
                for (int g = 1; g < 4; ++g) if (gsc[g] > best) { best = gsc[g]; grp = g; }
                float a[4], s4[4];
#pragma unroll
                for (int k = 0; k < 4; ++k) { a[k] = sel[k]; s4[k] = sc[k]; }
#pragma unroll
                for (int g = 1; g < 4; ++g) if (grp == g) {
#pragma unroll
                    for (int k = 0; k < 4; ++k) { a[k] = sel[4 * g + k]; s4[k] = sc[4 * g + k]; } }
                int i1 = 0; float m1 = a[0];
#pragma unroll
                for (int k = 1; k < 4; ++k) if (a[k] > m1) { m1 = a[k]; i1 = k; }
                int i2 = -1; float m2 = -3.0e38f;
#pragma unroll
                for (int k = 0; k < 4; ++k) if (k != i1 && a[k] > m2) { m2 = a[k]; i2 = k; }
                float w1 = s4[0], w2 = s4[0];
#pragma unroll
                for (int k = 1; k < 4; ++k) { if (i1 == k) w1 = s4[k]; if (i2 == k) w2 = s4[k]; }
                const float inv = 1.0f / (w1 + w2);
                if ((F.lane & 15) == 0) {
                    const int tl = F.wave * 16 + rq + (F.lane >> 4);
                    const int e1 = grp * 4 + i1, e2 = grp * 4 + i2;
                    float* tw = (float*)(ws + WS_TOKW); const int row = rb * 128 + tl;
                    tw[row * 2] = w1 * inv; tw[row * 2 + 1] = w2 * inv;
                    const int k1 = __hip_atomic_fetch_add(cntL + e1, 1, __ATOMIC_RELAXED, __HIP_MEMORY_SCOPE_WORKGROUP), k2 = __hip_atomic_fetch_add(cntL + e2, 1, __ATOMIC_RELAXED, __HIP_MEMORY_SCOPE_WORKGROUP);
                    selL[tl * 2] = (e1 << 20) | k1; selL[tl * 2 + 1] = (e2 << 20) | k2;
                }
            }
        }
        if (ROUTER) {
            __syncthreads();
            if (F.tid < 16) { baseL[F.tid] = (int)__hip_atomic_fetch_add((unsigned*)(ws + WS_CTL) + CW_GCNT + 64 * (chunk * NL + layer) + F.tid, (unsigned)cntL[F.tid], __ATOMIC_RELAXED, __HIP_MEMORY_SCOPE_AGENT); }
            __syncthreads();
            if (F.tid < 256) { const int sv = selL[F.tid], e = sv >> 20, lp = baseL[e] + (sv & 0xfffff);
                ((int*)(ws + WS_LIST))[e * TC + lp] = rb * 128 + (F.tid >> 1); ((int*)(ws + WS_TOKPOS))[(rb * 128) * 2 + F.tid] = (e << 20) | lp; }
            __syncthreads();
            if (F.tid < 16) cntL[F.tid] = 0;
            __syncthreads();
        }
    }
}

DI float sum16(float v) { v += __shfl_xor(v, 1); v += __shfl_xor(v, 2); v += __shfl_xor(v, 4); v += __shfl_xor(v, 8); return v; }

DI void head_norm4(bf16* p, const f32x4 g, int lane) {
    const v2u raw = *(const v2u*)(p + 4 * lane);
    f32x4 f = {bf_lo(raw.x), bf_hi(raw.x), bf_lo(raw.y), bf_hi(raw.y)};
    const float ss = sum16((f.x * f.x + f.y * f.y) + (f.z * f.z + f.w * f.w));
    const float rs = 1.0f / sqrtf(ss * (1.0f / 64.0f) + EPS);
    f = f * rs * g;
    v2u o; o.x = cvt_pk_bf16(f.x, f.y); o.y = cvt_pk_bf16(f.z, f.w);
    *(v2u*)(p + 4 * lane) = o;
}

DI void prep1_phase(const Frame& F, const Args& A, int chunk, int layer) {
    unsigned char* ws = F.ws;
    bf16* PROJ = (bf16*)(ws + WS_PROJ);
    float* LOGF = (float*)(ws + WS_LOGF); float* ROPE = (float*)(ws + WS_ROPE);
    const int* positions = (const int*)inp(F, 2);
    const int lane = F.lane, d4 = (4 * lane) & 63;
    f32x4 gh[4];
    gh[0] = *(const f32x4*)(inp(F, 9) + layer * 64 + d4); gh[1] = *(const f32x4*)(inp(F, 10) + layer * 64 + d4);
    gh[2] = *(const f32x4*)(inp(F, 17) + layer * 64 + d4); gh[3] = *(const f32x4*)(inp(F, 18) + layer * 64 + d4);
    const f32x4 g_lq = *(const f32x4*)(inp(F, 11) + layer * 256 + 4 * lane);
    const f32x2 g_lkv = *(const f32x2*)(inp(F, 12) + layer * 128 + 2 * lane);
    const float fb = inp(F, 8)[layer * 4 + (lane & 3)];
    const float invf = exp2f(-(float)(lane & 15) * (13.287712379549449f / 16.0f));
    const int gw = F.bx * NWAVES + F.wave, NGW = F.G * NWAVES;
    constexpr int HOFF[4] = {PA_Q, PA_K, PD_Q, PD_K};
    for (int r0 = gw * 16; r0 < TC; r0 += NGW * 16) {
        for (int rq = 0; rq < 16; rq += 4) {
            v2u rh[4][4], rc[4]; unsigned rkv[4];
#pragma unroll
            for (int rr = 0; rr < 4; ++rr) { const bf16* pr = PROJ + (size_t)(r0 + rq + rr) * PS;
#pragma unroll
                for (int k = 0; k < 4; ++k) rh[rr][k] = *(const v2u*)(pr + HOFF[k] + 4 * lane);
                rc[rr] = *(const v2u*)(pr + PC_CQ + 4 * lane); rkv[rr] = *(const unsigned*)(pr + PC_CKV + 2 * lane); }
            const int rowl = r0 + rq + (lane >> 4), il = lane & 15; bf16* prl = PROJ + (size_t)rowl * PS;
            const float t1 = bf2f(prl[PC_KR + il]), t2 = bf2f(prl[PC_KR + 16 + il]);
            const float pos = (float)positions[(size_t)chunk * TC + rowl];
            const int rowf = r0 + rq + ((lane >> 2) & 3);
            const float fav = bf2f(PROJ[(size_t)rowf * PS + PC_FA + (lane & 3)]);
#pragma unroll
            for (int rr = 0; rr < 4; ++rr) { bf16* pr = PROJ + (size_t)(r0 + rq + rr) * PS;
                f32x4 f[4]; float ss[4];
#pragma unroll
                for (int k = 0; k < 4; ++k) { f[k] = (f32x4){bf_lo(rh[rr][k].x), bf_hi(rh[rr][k].x), bf_lo(rh[rr][k].y), bf_hi(rh[rr][k].y)}; ss[k] = (f[k].x * f[k].x + f[k].y * f[k].y) + (f[k].z * f[k].z + f[k].w * f[k].w); }
#pragma unroll
                for (int o = 1; o < 16; o <<= 1) {
#pragma unroll
                    for (int k = 0; k < 4; ++k) ss[k] += __shfl_xor(ss[k], o); }
#pragma unroll
                for (int k = 0; k < 4; ++k) { const float rs = 1.0f / sqrtf(ss[k] * (1.0f / 64.0f) + EPS); f[k] = f[k] * rs * gh[k];
                    v2u o; o.x = cvt_pk_bf16(f[k].x, f[k].y); o.y = cvt_pk_bf16(f[k].z, f[k].w); *(v2u*)(pr + HOFF[k] + 4 * lane) = o; }
            }
            {
                f32x4 fq[4]; float a[4], b[4], s1[4], s2[4];
#pragma unroll
                for (int rr = 0; rr < 4; ++rr) { fq[rr] = (f32x4){bf_lo(rc[rr].x), bf_hi(rc[rr].x), bf_lo(rc[rr].y), bf_hi(rc[rr].y)}; a[rr] = bf_lo(rkv[rr]); b[rr] = bf_hi(rkv[rr]);
                    s1[rr] = (fq[rr].x * fq[rr].x + fq[rr].y * fq[rr].y) + (fq[rr].z * fq[rr].z + fq[rr].w * fq[rr].w); s2[rr] = a[rr] * a[rr] + b[rr] * b[rr]; }
#pragma unroll
                for (int o = 1; o < 64; o <<= 1) {
#pragma unroll
                    for (int rr = 0; rr < 4; ++rr) { s1[rr] += __shfl_xor(s1[rr], o); s2[rr] += __shfl_xor(s2[rr], o); } }
#pragma unroll
                for (int rr = 0; rr < 4; ++rr) { bf16* pr = PROJ + (size_t)(r0 + rq + rr) * PS;
                    const float r1 = 1.0f / sqrtf(s1[rr] * (1.0f / 256.0f) + EPS), r2 = 1.0f / sqrtf(s2[rr] * (1.0f / 128.0f) + EPS);
                    const f32x4 q = fq[rr] * r1 * g_lq; v2u o; o.x = cvt_pk_bf16(q.x, q.y); o.y = cvt_pk_bf16(q.z, q.w);
                    *(v2u*)(pr + PC_CQ + 4 * lane) = o; *(unsigned*)(pr + PC_CKV + 2 * lane) = cvt_pk_bf16(a[rr] * r2 * g_lkv.x, b[rr] * r2 * g_lkv.y); }
            }
            {
                const float ang = pos * invf;
                float sn, cs; sincosf(ang, &sn, &cs);
                const unsigned o = cvt_pk_bf16(t1 * cs - t2 * sn, t1 * sn + t2 * cs);
                prl[PC_KR + il] = (bf16)(o & 0xffffu); prl[PC_KR + 16 + il] = (bf16)(o >> 16);
                ROPE[(size_t)rowl * 32 + il] = cs; ROPE[(size_t)rowl * 32 + 16 + il] = sn;
            }
            if (lane < 16) {
                const float v = fav + fb;
                LOGF[(size_t)rowf * 4 + (lane & 3)] = (v > 0.f) ? -log1pf(expf(-v)) : v - log1pf(expf(v));
            }
        }
    }
}

constexpr float QSCALE_C = 0.10206207261596577f * LOG2E;
DI void prep2_phase(const Frame& F, const Args& A, int layer) {
    unsigned char* ws = F.ws;
    const bf16* PROJ = (const bf16*)(ws + WS_PROJ); const bf16* QKVC = (const bf16*)(ws + WS_QKVC); const float* ROPE = (const float*)(ws + WS_ROPE);
    bf16* QC = (bf16*)(ws + WS_QC); bf16* KC = (bf16*)(ws + WS_KC);
    const int lane = F.lane, hh = lane >> 4, jj = lane & 15;
    LAS float* sq = (LAS float*)(F.lds + F.wave * 8192);
    LAS float* sk = sq + 384;
    LAS bf16* sb = (LAS bf16*)(sq + 768);
    float gq[6], gk[6];
#pragma unroll
    for (int k = 0; k < 6; ++k) { gq[k] = inp(F, 15)[layer * 96 + jj + 16 * k] * QSCALE_C; gk[k] = inp(F, 16)[layer * 96 + jj + 16 * k]; }
    const int gw = F.bx * NWAVES + F.wave, NGW = F.G * NWAVES;
    for (int r0 = gw * 16; r0 < TC; r0 += NGW * 16) {
        for (int rr = 0; rr < 16; ++rr) {
            const int row = r0 + rr;
            const bf16* qrow = QKVC + (size_t)row * 1024;
            if (lane < 48) { const v4u raw = *(const v4u*)(qrow + 8 * lane); LAS float* d = sq + 8 * lane;
                d[0] = bf_lo(raw.x); d[1] = bf_hi(raw.x); d[2] = bf_lo(raw.y); d[3] = bf_hi(raw.y); d[4] = bf_lo(raw.z); d[5] = bf_hi(raw.z); d[6] = bf_lo(raw.w); d[7] = bf_hi(raw.w); }
            { const int o = 8 * jj;
              if (o < 64) { const v4u raw = *(const v4u*)(qrow + 384 + 128 * hh + o); LAS float* d = sk + 96 * hh + o;
                d[0] = bf_lo(raw.x); d[1] = bf_hi(raw.x); d[2] = bf_lo(raw.y); d[3] = bf_hi(raw.y); d[4] = bf_lo(raw.z); d[5] = bf_hi(raw.z); d[6] = bf_lo(raw.w); d[7] = bf_hi(raw.w); } }
            if (lane < 4) { const v4u raw = *(const v4u*)(PROJ + (size_t)row * PS + PC_KR + 8 * lane);
                const float f[8] = {bf_lo(raw.x), bf_hi(raw.x), bf_lo(raw.y), bf_hi(raw.y), bf_lo(raw.z), bf_hi(raw.z), bf_lo(raw.w), bf_hi(raw.w)};
#pragma unroll
                for (int h = 0; h < 4; ++h)
#pragma unroll
                    for (int i = 0; i < 8; ++i) sk[96 * h + 64 + 8 * lane + i] = f[i]; }
            const float cs = ROPE[(size_t)row * 32 + jj], sn = ROPE[(size_t)row * 32 + 16 + jj];
            __builtin_amdgcn_wave_barrier(); asm volatile("s_waitcnt lgkmcnt(0)" ::: "memory");
            { const float t1 = sq[96 * hh + 64 + jj], t2 = sq[96 * hh + 80 + jj];
              __builtin_amdgcn_wave_barrier();
              sq[96 * hh + 64 + jj] = t1 * cs - t2 * sn; sq[96 * hh + 80 + jj] = t1 * sn + t2 * cs; }
            __builtin_amdgcn_wave_barrier(); asm volatile("s_waitcnt lgkmcnt(0)" ::: "memory");
            float qv[6], kv[6], sq2 = 0.f, sk2 = 0.f;
#pragma unroll
            for (int k = 0; k < 6; ++k) { qv[k] = sq[96 * hh + jj + 16 * k]; kv[k] = sk[96 * hh + jj + 16 * k]; sq2 += qv[k] * qv[k]; sk2 += kv[k] * kv[k]; }
            const float rq = 1.0f / sqrtf(sum16(sq2) * (1.0f / 96.0f) + EPS), rk = 1.0f / sqrtf(sum16(sk2) * (1.0f / 96.0f) + EPS);
            __builtin_amdgcn_wave_barrier();
#pragma unroll
            for (int k = 0; k < 6; ++k) { const unsigned o = cvt_pk_bf16(qv[k] * rq * gq[k], kv[k] * rk * gk[k]);
                sb[96 * hh + jj + 16 * k] = (bf16)(o & 0xffffu); sb[384 + 96 * hh + jj + 16 * k] = (bf16)(o >> 16); }
            __builtin_amdgcn_wave_barrier(); asm volatile("s_waitcnt lgkmcnt(0)" ::: "memory");
            if (lane < 48) { *(v4u*)(QC + (size_t)row * 384 + 8 * lane) = *(const LAS v4u*)(sb + 8 * lane); *(v4u*)(KC + (size_t)row * 384 + 8 * lane) = *(const LAS v4u*)(sb + 384 + 8 * lane); }
            __builtin_amdgcn_wave_barrier(); asm volatile("s_waitcnt lgkmcnt(0)" ::: "memory");
        }
    }
}

DI void route_phase(const Frame& F) {
    unsigned char* ws = F.ws;
    const int* CNT = (const int*)(ws + WS_CNT); const int* TOKE = (const int*)(ws + WS_TOKE); int* TOKPOS = (int*)(ws + WS_TOKPOS);
    int* TILEEXP = (int*)(ws + WS_TILEEXP);
    const bf16* H = (const bf16*)(ws + WS_H); bf16* HS = (bf16*)(ws + WS_HS);
    LAS int* cntL = (LAS int*)F.lds;
    LAS int* totL = cntL + 4096;
    LAS int* preL = totL + 16;
    LAS int* baseL = preL + 16;
    LAS int* wc0L = baseL + 16;
    LAS int* posL = wc0L + 16;
    constexpr int NRB = TC / 128;
    for (int idx = F.tid; idx < NRB * 16; idx += NTHREADS) cntL[idx] = CNT[idx];
    __syncthreads();
    for (int rb = F.bx; rb < NRB; rb += F.G) {
        if (F.tid < 16) { int tot = 0, pre = 0; for (int t = 0; t < NRB; ++t) { const int c = cntL[t * 16 + F.tid]; if (t < rb) pre += c; tot += c; } totL[F.tid] = tot; preL[F.tid] = pre; }
        __syncthreads();
        if (F.tid == 0) { int base = 0; for (int e = 0; e < 16; ++e) { baseL[e] = base; base += ((totL[e] + 255) >> 8) << 8; }
            if (rb == 0) { int m = 0; for (int e = 0; e < 16; ++e) { const int nt = (totL[e] + 255) >> 8; for (int j = 0; j < nt; ++j) TILEEXP[m++] = e; } TILEEXP[NMT_WORD] = m; } }
        __syncthreads();
        if (F.tid < 128) {
            const int t = rb * 128 + F.tid; const int e0 = TOKE[t * 2], e1 = TOKE[t * 2 + 1];
            int rk0 = 0, rk1 = 0;
            const unsigned long long lt = (1ull << F.lane) - 1ull;
            for (int e = 0; e < 16; ++e) {
                const unsigned long long m = __ballot(e0 == e || e1 == e);
                const int r = __popcll(m & lt);
                if (e0 == e) rk0 = r; if (e1 == e) rk1 = r;
                if (F.wave == 0 && F.lane == 0) wc0L[e] = __popcll(m);
            }
            asm volatile("s_waitcnt lgkmcnt(0)" ::: "memory");
            posL[256 + F.tid * 2] = rk0; posL[256 + F.tid * 2 + 1] = rk1;
        }
        __syncthreads();
        if (F.tid < 128) {
            const int t = rb * 128 + F.tid; const int e0 = TOKE[t * 2], e1 = TOKE[t * 2 + 1];
            const int add0 = (F.wave == 1) ? wc0L[e0] : 0, add1 = (F.wave == 1) ? wc0L[e1] : 0;
            const int p0 = baseL[e0] + preL[e0] + posL[256 + F.tid * 2] + add0, p1 = baseL[e1] + preL[e1] + posL[256 + F.tid * 2 + 1] + add1;
            TOKPOS[t * 2] = p0; TOKPOS[t * 2 + 1] = p1; posL[F.tid * 2] = p0; posL[F.tid * 2 + 1] = p1;
        }
        __syncthreads();
        for (int it = F.wave * 32; it < F.wave * 32 + 32; ++it) {
            const int tl = it >> 1; const int pos = posL[it];
            const v4u* src = (const v4u*)(H + (size_t)(rb * 128 + tl) * 1024); v4u* dst = (v4u*)(HS + (size_t)pos * 1024);
            const v4u a = src[F.lane], b = src[64 + F.lane]; dst[F.lane] = a; dst[64 + F.lane] = b;
        }
        __syncthreads();
    }
}

namespace att {
constexpr int KBYTES = 12288, VBYTES = 8192;
constexpr int NSLOT = 3, L_K = 0, L_V = NSLOT * KBYTES, L_WSF = NSLOT * (KBYTES + VBYTES), L_BIAS = L_WSF + 1024, L_REL = L_BIAS + 8192, L_SCAN = L_REL + 1056, L_DONE = L_SCAN + 64, L_OST = L_DONE + 64, L_END = L_OST + 8 * 4096;
static_assert(L_END <= RING_BYTES, "attention LDS");
DI int crow(int r, int hi) { return (r & 3) + 8 * (r >> 2) + 4 * hi; }
#define MFMA32(a, b, c) __builtin_amdgcn_mfma_f32_32x32x16_bf16((a), (b), (c), 0, 0, 0)
typedef short v4i16_t __attribute__((ext_vector_type(4)));
DI s16x4 vtr(const LAS unsigned char* p) { return __builtin_bit_cast(s16x4, __builtin_amdgcn_ds_read_tr16_b64_v4i16((LAS v4i16_t*)p)); }
DI float max3f(float a, float b, float c) { return __builtin_fmaxf(__builtin_fmaxf(a, b), c); }
DI float swap_max(float m) { auto rr = __builtin_amdgcn_permlane32_swap(__float_as_uint(m), __float_as_uint(m), false, false); return fmaxf(__uint_as_float(rr[0]), __uint_as_float(rr[1])); }
DI float swap_sum(float m) { auto rr = __builtin_amdgcn_permlane32_swap(__float_as_uint(m), __float_as_uint(m), false, false); return __uint_as_float(rr[0]) + __uint_as_float(rr[1]); }

struct Tens { const bf16* Q; const bf16* K; const bf16* V; int pq, pk, pv; bf16* O; float qscale; };

template <int MIX>
DI void attn_unit(const Frame& F, const Tens& T, int b, int h, int qb, const float* logf, const float* relb) {
    constexpr int DQK = (MIX == 2) ? 96 : 64, NKS = DQK / 16;
    LAS unsigned char* lds = F.lds;
    const int tid = F.tid, lane = F.lane, wid = F.wave, r32 = lane & 31, hi = lane >> 5;
    const int rowbase = b * S, q0 = qb * 256, q0w = q0 + 32 * wid, cw = q0w >> 6;
    LAS float* wsf = (LAS float*)(lds + L_WSF) + wid * 32;
    LAS float* biasL = (LAS float*)(lds + L_BIAS);
    LAS float* relL = (LAS float*)(lds + L_REL);
    __syncthreads();
    const int t_hi = 4 * qb + 3;
    const int t_lo = (MIX == 3) ? ((4 * qb - 8) > 0 ? (4 * qb - 8) : 0) : 0;
    const int ntile = t_hi - t_lo + 1;
    const char* Kb = (const char*)(T.K + (size_t)rowbase * T.pk); const char* Vb = (const char*)(T.V + (size_t)rowbase * T.pv);
    const unsigned koff0 = (unsigned)(((tid & 63) * T.pk + 8 * (tid >> 6)) * 2);
    const unsigned voff = (unsigned)(((16 * (wid & 3) + (lane >> 2)) * T.pv + (wid >> 2) * 32 + (lane & 3) * 8) * 2);
    const bool k2 = (DQK == 96) && (wid < 4);
#define ATT_ISSUE(t, slot) do { const char* kt = Kb + (size_t)(t) * 128 * T.pk; const char* vt = Vb + (size_t)(t) * 128 * T.pv; \
        __builtin_amdgcn_global_load_lds((const unsigned*)(kt + koff0), (LAS unsigned*)(lds + L_K + (slot) * KBYTES + wid * 1024), 16, 0, 0); \
        if (k2) __builtin_amdgcn_global_load_lds((const unsigned*)(kt + koff0 + 128), (LAS unsigned*)(lds + L_K + (slot) * KBYTES + 8192 + wid * 1024), 16, 0, 0); \
        __builtin_amdgcn_global_load_lds((const unsigned*)(vt + voff), (LAS unsigned*)(lds + L_V + (slot) * VBYTES + wid * 1024), 16, 0, 0); } while (0)
#define ATT_WAITBAR(n) asm volatile("s_waitcnt vmcnt(" #n ") lgkmcnt(0)\n\ts_barrier" ::: "memory")
#define ATT_WAIT_NEWEST() do { if (k2) ATT_WAITBAR(3); else ATT_WAITBAR(2); } while (0)
#define ATT_TILE(it) ((MIX == 1) ? (t_hi - (it)) : (t_lo + (it)))
    ATT_ISSUE(ATT_TILE(0), 0);
    if (ntile > 1) ATT_ISSUE(ATT_TILE(1), 1);
    if (MIX == 0) {
        LAS float* scanL = (LAS float*)(lds + L_SCAN);
        float lf[4]; float run = 0.f;
#pragma unroll
        for (int i = 0; i < 4; ++i) { run += logf[(size_t)(rowbase + 4 * tid + i) * 4 + h]; lf[i] = run; }
        float inc = run;
#pragma unroll
        for (int o = 1; o < 64; o <<= 1) { const float t = __shfl_up(inc, o); if (lane >= o) inc += t; }
        if (lane == 63) scanL[wid] = inc;
        asm volatile("s_waitcnt lgkmcnt(0)\n\ts_barrier" ::: "memory");
        float off = inc - run;
        for (int w = 0; w < wid; ++w) off += scanL[w];
#pragma unroll
        for (int i = 0; i < 4; ++i) biasL[4 * tid + i] = -LOG2E * (off + lf[i]);
    }
    if (MIX == 3) { const float far = relb[256]; for (int i = tid; i < 257; i += NTHREADS) relL[i] = (relb[i] - far) * LOG2E; }
    bf16x8 qr[NKS];
    {
        const char* qb_ = (const char*)(T.Q + (size_t)(rowbase + q0w) * T.pq); const unsigned qoff = (unsigned)((r32 * T.pq + 8 * hi) * 2);
#pragma unroll
        for (int d0 = 0; d0 < NKS; ++d0) { const v4u raw = *(const v4u*)(qb_ + qoff + 32 * d0); v4u s;
            s.x = cvt_pk_bf16(bf_lo(raw.x) * T.qscale, bf_hi(raw.x) * T.qscale); s.y = cvt_pk_bf16(bf_lo(raw.y) * T.qscale, bf_hi(raw.y) * T.qscale);
            s.z = cvt_pk_bf16(bf_lo(raw.z) * T.qscale, bf_hi(raw.z) * T.qscale); s.w = cvt_pk_bf16(bf_lo(raw.w) * T.qscale, bf_hi(raw.w) * T.qscale);
            qr[d0] = __builtin_bit_cast(bf16x8, s); }
    }
    f32x16 o0, o1;
#pragma unroll
    for (int i = 0; i < 16; ++i) { o0[i] = 0.f; o1[i] = 0.f; }
    float mrun = -1.0e30f, lrun = 0.f, arun = 0.f;
    bool bdone = false;
    LAS int* doneL = (LAS int*)(lds + L_DONE);
    ATT_WAITBAR(0);
    int slot = 0;
    for (int it = 0; it < ntile; ++it) {
        const int t = ATT_TILE(it);
        const bool more = (it + 2 < ntile);
        if (more) { const int s2 = (slot == 0) ? 2 : slot - 1; ATT_ISSUE(ATT_TILE(it + 2), s2); }
        const bool part = (MIX == 3) ? (t <= cw && t >= cw - 8) : ((MIX == 1) ? (t <= cw && !bdone) : (t <= cw));
        if (part) {
            const LAS unsigned char* kb = lds + L_K + slot * KBYTES + hi * 1024 + r32 * 16;
            f32x16 p0, p1;
            if (MIX == 0) {
                const LAS f32x4* bp = (const LAS f32x4*)(biasL + 64 * t + 4 * hi);
#pragma unroll
                for (int g = 0; g < 4; ++g) { const f32x4 b0 = bp[2 * g], b1 = bp[8 + 2 * g];
                    p0[4 * g] = b0.x; p0[4 * g + 1] = b0.y; p0[4 * g + 2] = b0.z; p0[4 * g + 3] = b0.w; p1[4 * g] = b1.x; p1[4 * g + 1] = b1.y; p1[4 * g + 2] = b1.z; p1[4 * g + 3] = b1.w; }
            } else {
#pragma unroll
                for (int i = 0; i < 16; ++i) { p0[i] = 0.f; p1[i] = 0.f; }
            }
#pragma unroll
            for (int d0 = 0; d0 < NKS; ++d0) { const bf16x8 a0 = *(const LAS bf16x8*)(kb + d0 * 2048), a1 = *(const LAS bf16x8*)(kb + d0 * 2048 + 512);
                p0 = MFMA32(a0, qr[d0], p0); p1 = MFMA32(a1, qr[d0], p1); }
            const int qabs = q0w + r32, kv0 = 64 * t + 4 * hi;
            if (MIX == 1) {
                const bool diag = (t == cw);
                float lb0[16], lb1[16], gsum[8];
#pragma unroll
                for (int g = 0; g < 8; ++g) gsum[g] = 0.f;
#pragma unroll
                for (int i = 0; i < 16; ++i) {
                    const int kvA = kv0 + (i & 3) + 8 * (i >> 2);
                    { const float z = p0[i]; const float sp = fmaxf(z, 0.f) + fast_log2(1.0f + fast_exp2(-fabsf(z))); const bool valid = !diag || (kvA < qabs);
                      lb0[i] = valid ? z - sp : -1.0e30f; const float lk = valid ? -sp : 0.f; p0[i] = lk; gsum[i >> 2] += lk; }
                    { const float z = p1[i]; const float sp = fmaxf(z, 0.f) + fast_log2(1.0f + fast_exp2(-fabsf(z))); const bool valid = !diag || (kvA + 32 < qabs);
                      lb1[i] = valid ? z - sp : -1.0e30f; const float lk = valid ? -sp : 0.f; p1[i] = lk; gsum[4 + (i >> 2)] += lk; }
                }
                float Lg[8], Hg[8];
#pragma unroll
                for (int g = 0; g < 8; ++g) { auto rr = __builtin_amdgcn_permlane32_swap(__float_as_uint(gsum[g]), __float_as_uint(gsum[g]), false, false); Lg[g] = __uint_as_float(rr[0]); Hg[g] = __uint_as_float(rr[1]); }
                float suf = arun;
#pragma unroll
                for (int g = 7; g >= 0; --g) {
                    const float ag = suf + (hi == 0 ? Hg[g] : 0.f);
                    float within = 0.f;
#pragma unroll
                    for (int j = 3; j >= 0; --j) {
                        const int i = (g & 3) * 4 + j;
                        if (g < 4) { const float lk = p0[i]; p0[i] = fast_exp2(lb0[i] + ag + within); within += lk; }
                        else { const float lk = p1[i]; p1[i] = fast_exp2(lb1[i] + ag + within); within += lk; }
                    }
                    suf += Lg[g] + Hg[g];
                }
                arun = suf;
                if (__all(arun < -150.0f)) bdone = true;
            } else {
                if (MIX == 0) {
                    if (t == cw) {
#pragma unroll
                        for (int i = 0; i < 16; ++i) { const int kvA = kv0 + (i & 3) + 8 * (i >> 2); if (kvA > qabs) p0[i] = -1.0e30f; if (kvA + 32 > qabs) p1[i] = -1.0e30f; }
                    }
                }
                if (MIX == 3 && (cw - t) < 3) {
#pragma unroll
                    for (int i = 0; i < 16; ++i) { const int kvA = kv0 + (i & 3) + 8 * (i >> 2); int d0i = qabs - kvA; int d1i = d0i - 32;
                        d0i = d0i < -128 ? -128 : (d0i > 128 ? 128 : d0i); d1i = d1i < -128 ? -128 : (d1i > 128 ? 128 : d1i);
                        p0[i] += relL[d0i + 128]; p1[i] += relL[d1i + 128]; }
                }
                float rm = max3f(p0[0], p1[0], p0[1]), rm2 = max3f(p1[1], p0[2], p1[2]);
#pragma unroll
                for (int i = 3; i < 15; i += 2) { rm = max3f(rm, p0[i], p1[i]); rm2 = max3f(rm2, p0[i + 1], p1[i + 1]); }
                rm = max3f(rm, rm2, fmaxf(p0[15], p1[15]));
                rm = swap_max(rm);
                const float mnew = fmaxf(mrun, rm);
                const float f = fast_exp2(mrun - mnew);
                mrun = mnew; lrun *= f;
                float sacc = 0.f;
#pragma unroll
                for (int i = 0; i < 16; ++i) { p0[i] = fast_exp2(p0[i] - mnew); p1[i] = fast_exp2(p1[i] - mnew); sacc += p0[i] + p1[i]; }
                lrun += sacc;
                if (__any(f != 1.0f)) {
                    if (hi == 0) wsf[r32] = f;
                    __builtin_amdgcn_wave_barrier(); asm volatile("s_waitcnt lgkmcnt(0)" ::: "memory");
#pragma unroll
                    for (int i = 0; i < 16; ++i) { const float ff = wsf[crow(i, hi)]; o0[i] *= ff; o1[i] *= ff; }
                    __builtin_amdgcn_wave_barrier();
                }
            }
            v4u pw[4];
#pragma unroll
            for (int s = 0; s < 2; ++s) { pw[s].x = cvt_pk_bf16(p0[8 * s], p0[8 * s + 1]); pw[s].y = cvt_pk_bf16(p0[8 * s + 2], p0[8 * s + 3]); pw[s].z = cvt_pk_bf16(p0[8 * s + 4], p0[8 * s + 5]); pw[s].w = cvt_pk_bf16(p0[8 * s + 6], p0[8 * s + 7]);
                pw[2 + s].x = cvt_pk_bf16(p1[8 * s], p1[8 * s + 1]); pw[2 + s].y = cvt_pk_bf16(p1[8 * s + 2], p1[8 * s + 3]); pw[2 + s].z = cvt_pk_bf16(p1[8 * s + 4], p1[8 * s + 5]); pw[2 + s].w = cvt_pk_bf16(p1[8 * s + 6], p1[8 * s + 7]); }
            const unsigned vp = (unsigned)(size_t)(lds + L_V + slot * VBYTES + ((lane >> 4) & 1) * 32 + (lane & 3) * 8 + (4 * hi + ((lane & 15) >> 2)) * 64);
#define ATT_TR(dst, off) asm volatile("ds_read_b64_tr_b16 %0, %1 offset:%c2" : "=&v"(dst) : "v"(vp), "i"(off) : "memory")
            {
                s16x4 lo[4], hh[4];
#pragma unroll
                for (int ks = 0; ks < 4; ++ks) { ATT_TR(lo[ks], ks * 1024); ATT_TR(hh[ks], ks * 1024 + 512); }
                asm volatile("s_waitcnt lgkmcnt(0)" ::: "memory"); __builtin_amdgcn_sched_barrier(0);
#pragma unroll
                for (int ks = 0; ks < 4; ++ks) { const bf16x8 vf = {lo[ks][0], lo[ks][1], lo[ks][2], lo[ks][3], hh[ks][0], hh[ks][1], hh[ks][2], hh[ks][3]}; o0 = MFMA32(__builtin_bit_cast(bf16x8, pw[ks]), vf, o0); }
#pragma unroll
                for (int ks = 0; ks < 4; ++ks) { ATT_TR(lo[ks], 4096 + ks * 1024); ATT_TR(hh[ks], 4096 + ks * 1024 + 512); }
                asm volatile("s_waitcnt lgkmcnt(0)" ::: "memory"); __builtin_amdgcn_sched_barrier(0);
#pragma unroll
                for (int ks = 0; ks < 4; ++ks) { const bf16x8 vf = {lo[ks][0], lo[ks][1], lo[ks][2], lo[ks][3], hh[ks][0], hh[ks][1], hh[ks][2], hh[ks][3]}; o1 = MFMA32(__builtin_bit_cast(bf16x8, pw[ks]), vf, o1); }
            }
#undef ATT_TR
        }
        if (MIX == 1) { if (lane == 0) doneL[(it & 1) * 8 + wid] = bdone ? 1 : 0; }
        if (more) ATT_WAIT_NEWEST(); else ATT_WAITBAR(0);
        slot = (slot == 2) ? 0 : slot + 1;
        if (MIX == 1) {
            const int fl = (lane < 8) ? doneL[(it & 1) * 8 + lane] : 1;
            if (__all(fl != 0)) { ATT_WAITBAR(0); break; }
        }
    }
    {
        if (MIX != 1) {
            const float lt = swap_sum(lrun);
            if (hi == 0) wsf[r32] = fast_rcp(lt);
            __builtin_amdgcn_wave_barrier(); asm volatile("s_waitcnt lgkmcnt(0)" ::: "memory");
#pragma unroll
            for (int i = 0; i < 16; ++i) { const float ff = wsf[crow(i, hi)]; o0[i] *= ff; o1[i] *= ff; }
        }
        LAS bf16* stg = (LAS bf16*)(lds + L_OST) + wid * 2048;
#pragma unroll
        for (int i = 0; i < 16; ++i) { const int orow = crow(i, hi); const unsigned pk = cvt_pk_bf16(o0[i], o1[i]); stg[orow * 64 + r32] = (bf16)(pk & 0xffffu); stg[orow * 64 + 32 + r32] = (bf16)(pk >> 16); }
        __builtin_amdgcn_wave_barrier(); asm volatile("s_waitcnt lgkmcnt(0)" ::: "memory");
        char* Ow = (char*)(T.O + (size_t)(rowbase + q0w) * 1024);
#pragma unroll
        for (int i = 0; i < 4; ++i) { const int row = i * 8 + (lane >> 3), ch = lane & 7; const v4u v = *(const LAS v4u*)(stg + row * 64 + ch * 8); *(v4u*)(Ow + (unsigned)((row * 1024 + ch * 8) * 2)) = v; }
    }
#undef ATT_ISSUE
#undef ATT_WAITBAR
#undef ATT_WAIT_NEWEST
#undef ATT_TILE
}

DI void attn_phase(const Frame& F, const Args& A, int layer) {
    unsigned char* ws = F.ws;
    const bf16* PROJ = (const bf16*)(ws + WS_PROJ); bf16* O = (bf16*)(ws + WS_O);
    const float* logf = (const float*)(ws + WS_LOGF);
    const float sc8 = 0.125f * LOG2E;
    for (int p = F.bx; p < NBC * 16; p += F.G) {
        const int bh = p >> 2, b = bh >> 2, h = bh & 3, x = p & 3;
        { Tens T{PROJ + PA_Q + 64 * h, PROJ + PA_K + 64 * h, PROJ + PA_V + 64 * h, PS, PS, PS, O + 0 + 64 * h, sc8};
          for (int j = 0; j < 2; ++j) attn_unit<0>(F, T, b, h, j ? 7 - x : x, logf, nullptr); }
        { Tens T{PROJ + PB_Q + 64 * h, PROJ + PB_K + 64 * h, PROJ + PB_V + 64 * h, PS, PS, PS, O + 256 + 64 * h, sc8};
          for (int j = 0; j < 2; ++j) attn_unit<1>(F, T, b, h, j ? 7 - x : x, nullptr, nullptr); }
        { Tens T{(const bf16*)(ws + WS_QC) + 96 * h, (const bf16*)(ws + WS_KC) + 96 * h, (const bf16*)(ws + WS_QKVC) + 384 + 128 * h + 64, 384, 384, 1024, O + 512 + 64 * h, 1.0f};
          for (int j = 0; j < 2; ++j) attn_unit<2>(F, T, b, h, j ? 7 - x : x, nullptr, nullptr); }
        { Tens T{PROJ + PD_Q + 64 * h, PROJ + PD_K + 64 * h, PROJ + PD_V + 64 * h, PS, PS, PS, O + 768 + 64 * h, sc8};
          const float* relb = inp(F, 19) + ((size_t)layer * 4 + h) * 257;
          for (int j = 0; j < 2; ++j) attn_unit<3>(F, T, b, h, j ? 7 - x : x, nullptr, relb); }
    }
    __syncthreads();
}
}
#ifndef MK_MULTI
#define MK_MULTI 0
#endif

using pg8::Unit; using pg8::Acc;
DI void pack8_store(bf16* p, const f32x4 v0, const f32x4 v1) { v4u w; w.x = cvt_pk_bf16(v0[0], v0[1]); w.y = cvt_pk_bf16(v0[2], v0[3]); w.z = cvt_pk_bf16(v1[0], v1[1]); w.w = cvt_pk_bf16(v1[2], v1[3]); *(v4u*)p = w; }
DI f32x4 sig4(const f32x4 v) { return (f32x4){sigmoid_f(v[0]), sigmoid_f(v[1]), sigmoid_f(v[2]), sigmoid_f(v[3])}; }
DI void unpack8(const v4u raw, f32x4& a, f32x4& b) { a = (f32x4){bf_lo(raw.x), bf_hi(raw.x), bf_lo(raw.y), bf_hi(raw.y)}; b = (f32x4){bf_lo(raw.z), bf_hi(raw.z), bf_lo(raw.w), bf_hi(raw.w)}; }

struct EpiStore {
    static constexpr bool PERM = true, CHAIN = false;
    bf16* O; int ldc; int sig_pn; float scale;
    DI void operator()(Acc& acc, const Unit& u, bool, const Unit&, int wr, int wc, int fr, int fq) const {
        const int row0 = u.pm * 256 + wr * 64 + fr, col0 = u.pn * 256 + wc * 32 + 8 * fq;
        const bool sg = u.pn >= sig_pn;
#pragma unroll
        for (int ai = 0; ai < 2; ++ai)
#pragma unroll
            for (int m = 0; m < 4; ++m) { bf16* rowp = O + (size_t)(row0 + ai * 128 + m * 16) * ldc + col0;
#pragma unroll
                for (int bj = 0; bj < 2; ++bj) { f32x4 v0 = acc[ai][bj][m][0], v1 = acc[ai][bj][m][1]; if (sg) { v0 = sig4(v0 * scale); v1 = sig4(v1 * scale); } pack8_store(rowp + bj * 128, v0, v1); } }
    }
};
struct EpiSwiGLU {
    static constexpr bool PERM = true, CHAIN = false;
    bf16* O;
    DI void operator()(Acc& acc, const Unit& u, bool, const Unit&, int wr, int wc, int fr, int fq) const {
        const int row0 = u.pm * 256 + wr * 64 + fr, col0 = u.pn * 128 + wc * 32 + 8 * fq;
#pragma unroll
        for (int ai = 0; ai < 2; ++ai)
#pragma unroll
            for (int m = 0; m < 4; ++m) { bf16* rowp = O + (size_t)(row0 + ai * 128 + m * 16) * 256 + col0;
                const f32x4 g0 = acc[ai][0][m][0], g1 = acc[ai][0][m][1];
                pack8_store(rowp, g0 * sig4(g0) * acc[ai][1][m][0], g1 * sig4(g1) * acc[ai][1][m][1]); }
    }
};
struct EpiGateChain {
    static constexpr bool PERM = true, CHAIN = true;
    const bf16* G;
    bf16* O;
    DI void operator()(Acc& acc, const Unit& u, bool, const Unit&, int wr, int wc, int fr, int fq) const {
        const int row0 = u.pm * 256 + wr * 64 + fr, col0 = u.pn * 256 + wc * 32 + 8 * fq, b = u.aux;
        const int wid = wr * 4 + wc, lane = fq * 16 + fr;
        const bf16* gt = G + ((size_t)((b * (TC / 256) + u.pm) * 4 + u.pn) * 65536) + (size_t)(wid * 64 + lane) * 8;
#pragma unroll
        for (int ai = 0; ai < 2; ++ai) {
            v4u gc[4][2];
#pragma unroll
            for (int m = 0; m < 4; ++m)
#pragma unroll
                for (int bj = 0; bj < 2; ++bj) gc[m][bj] = *(const v4u*)(gt + (size_t)(((ai * 4 + m) * 2 + bj) * 512) * 8);
#pragma unroll
            for (int m = 0; m < 4; ++m) {
                const size_t r = (size_t)(row0 + ai * 128 + m * 16);
#pragma unroll
                for (int bj = 0; bj < 2; ++bj) {
                    f32x4 c0, c1; unpack8(gc[m][bj], c0, c1);
                    if (b == 3) { pack8_store(O + r * 1024 + col0 + bj * 128, acc[ai][bj][m][0] * c0, acc[ai][bj][m][1] * c1);
                        acc[ai][bj][m][0] = (f32x4){0.f, 0.f, 0.f, 0.f}; acc[ai][bj][m][1] = (f32x4){0.f, 0.f, 0.f, 0.f}; }
                    else { acc[ai][bj][m][0] = acc[ai][bj][m][0] * c0; acc[ai][bj][m][1] = acc[ai][bj][m][1] * c1; }
                }
            }
            asm volatile("" ::: "memory");
        }
    }
};
struct EpiResGate {
    static constexpr bool PERM = true, CHAIN = false;
    const float* xin32; const bf16* xin16; bf16* xout; const float* modg;
    DI void operator()(Acc& acc, const Unit& u, bool, const Unit&, int wr, int wc, int fr, int fq) const {
        const int col0 = u.pn * 256 + wc * 32 + 8 * fq;
        const float* gv = modg + (size_t)((u.pm * 256) / S) * 6144 + col0;
        f32x4 g[2][2];
#pragma unroll
        for (int bj = 0; bj < 2; ++bj)
#pragma unroll
            for (int n = 0; n < 2; ++n) g[bj][n] = *(const f32x4*)(gv + bj * 128 + n * 4);
        const size_t off0 = (size_t)(u.pm * 256 + wr * 64 + fr) * D + col0;
        if (xin32) {
#pragma unroll
            for (int ai = 0; ai < 2; ++ai)
#pragma unroll
                for (int mp = 0; mp < 4; mp += 2) {
                    f32x4 x[2][2][2];
#pragma unroll
                    for (int mm = 0; mm < 2; ++mm)
#pragma unroll
                        for (int bj = 0; bj < 2; ++bj) { const float* p = xin32 + off0 + (size_t)(ai * 128 + (mp + mm) * 16) * D + bj * 128; x[mm][bj][0] = *(const f32x4*)p; x[mm][bj][1] = *(const f32x4*)(p + 4); }
#pragma unroll
                    for (int mm = 0; mm < 2; ++mm)
#pragma unroll
                        for (int bj = 0; bj < 2; ++bj) pack8_store(xout + off0 + (size_t)(ai * 128 + (mp + mm) * 16) * D + bj * 128, x[mm][bj][0] + g[bj][0] * acc[ai][bj][mp + mm][0], x[mm][bj][1] + g[bj][1] * acc[ai][bj][mp + mm][1]);
                    asm volatile("" ::: "memory"); }
        } else {
#pragma unroll
            for (int ai = 0; ai < 2; ++ai) {
                v4u xr[4][2];
#pragma unroll
                for (int m = 0; m < 4; ++m)
#pragma unroll
                    for (int bj = 0; bj < 2; ++bj) xr[m][bj] = *(const v4u*)(xin16 + off0 + (size_t)(ai * 128 + m * 16) * D + bj * 128);
#pragma unroll
                for (int m = 0; m < 4; ++m)
#pragma unroll
                    for (int bj = 0; bj < 2; ++bj) { f32x4 x0, x1; unpack8(xr[m][bj], x0, x1); pack8_store(xout + off0 + (size_t)(ai * 128 + m * 16) * D + bj * 128, x0 + g[bj][0] * acc[ai][bj][m][0], x1 + g[bj][1] * acc[ai][bj][m][1]); }
                asm volatile("" ::: "memory"); }
        }
    }
};
struct EpiMoeOut {
    static constexpr bool PERM = true, CHAIN = false;
    const bf16* xin; bf16* xout16; float* xout32; const float* modg; const bf16* Y; const int* tokpos; const float* tokw; const LAS int* tb;
    DI void operator()(Acc& acc, const Unit& u, bool, const Unit&, int wr, int wc, int fr, int fq) const {
        const int col0 = u.pn * 256 + wc * 32 + 8 * fq;
        const float* gv = modg + (size_t)((u.pm * 256) / S) * 6144 + col0;
        f32x4 g[2][2];
#pragma unroll
        for (int bj = 0; bj < 2; ++bj)
#pragma unroll
            for (int n = 0; n < 2; ++n) g[bj][n] = *(const f32x4*)(gv + bj * 128 + n * 4);
#pragma unroll
        for (int ai = 0; ai < 2; ++ai)
#pragma unroll
            for (int mp = 0; mp < 4; mp += 2) {
                v4u xr[2][2], ya[2][2], yb[2][2]; float w0[2], w1[2]; size_t off[2];
#pragma unroll
                for (int mm = 0; mm < 2; ++mm) { const int row = u.pm * 256 + ai * 128 + wr * 64 + (mp + mm) * 16 + fr; off[mm] = (size_t)row * D + col0;
                    const int s0 = tokpos[row * 2], s1 = tokpos[row * 2 + 1]; w0[mm] = tokw[row * 2]; w1[mm] = tokw[row * 2 + 1];
                    const int p0 = tb[s0 >> 20] * 256 + (s0 & 0xfffff), p1 = tb[s1 >> 20] * 256 + (s1 & 0xfffff);
                    const bf16* y0 = Y + (size_t)p0 * 1024 + col0; const bf16* y1 = Y + (size_t)p1 * 1024 + col0;
#pragma unroll
                    for (int bj = 0; bj < 2; ++bj) { xr[mm][bj] = *(const v4u*)(xin + off[mm] + bj * 128); ya[mm][bj] = *(const v4u*)(y0 + bj * 128); yb[mm][bj] = *(const v4u*)(y1 + bj * 128); } }
#pragma unroll
                for (int mm = 0; mm < 2; ++mm)
#pragma unroll
                    for (int bj = 0; bj < 2; ++bj) { f32x4 x0, x1, a0, a1, b0, b1; unpack8(xr[mm][bj], x0, x1); unpack8(ya[mm][bj], a0, a1); unpack8(yb[mm][bj], b0, b1);
                        const f32x4 r0 = x0 + g[bj][0] * (acc[ai][bj][mp + mm][0] + a0 * w0[mm] + b0 * w1[mm]), r1 = x1 + g[bj][1] * (acc[ai][bj][mp + mm][1] + a1 * w0[mm] + b1 * w1[mm]);
                        if (xout32) { *(f32x4*)(xout32 + off[mm] + bj * 128) = r0; *(f32x4*)(xout32 + off[mm] + bj * 128 + 4) = r1; } else pack8_store(xout16 + off[mm] + bj * 128, r0, r1); }
                asm volatile("" ::: "memory"); }
    }
};

struct SchedDense {
    int nM, nN, nwg, G, c; const char* A; const char* B; size_t atile, btile;
    DI void init(int nM_, int nN_, int G_, int c_, const void* A_, size_t atile_, const void* B_, size_t btile_) { nM = nM_; nN = nN_; nwg = nM * nN; G = G_; c = c_; A = (const char*)A_; B = (const char*)B_; atile = atile_; btile = btile_; }
    DI bool next(int i, Unit& u) const {
        const long L = (long)i * G + c; if (L >= nwg) return false;
        int wgid = (int)L; { const int q = nwg / 8, r = nwg % 8, xcd = wgid % 8, off = wgid / 8; wgid = (xcd < r ? xcd * (q + 1) : r * (q + 1) + (xcd - r) * q) + off; }
        const int nig = 8 * nN, gid = wgid / nig, fm = gid * 8, gsz = (nM - fm) < 8 ? (nM - fm) : 8;
        u.pm = fm + ((wgid % nig) % gsz); u.pn = (wgid % nig) / gsz; u.aux = 0;
        u.pa = A + (size_t)u.pm * atile; u.pb = B + (size_t)u.pn * btile; return true;
    }
};
struct SchedBranch {
    int ntile, G, c; const char* O; const char* W;
    DI bool next(int i, Unit& u) const {
        const long ti = (long)(i >> 2) * G + c; if (ti >= ntile) return false;
        const int b = i & 3; u.pm = (int)(ti >> 2); u.pn = (int)(ti & 3); u.aux = b;
        u.pa = O + (size_t)u.pm * (256 * 1024 * 2) + b * 512; u.pb = W + (size_t)b * (1024 * 256 * 2) + (size_t)u.pn * (256 * 256 * 2); return true;
    }
};
DI void moe_tables(const Frame& F, int set) {
    LAS int* ne = (LAS int*)(F.lds + MOET_OFF); LAS int* tb = ne + 16;
    __syncthreads();
    if (F.tid < 16) ne[F.tid] = (int)__hip_atomic_load((unsigned*)(F.ws + WS_CTL) + CW_GCNT + 64 * set + F.tid, __ATOMIC_RELAXED, __HIP_MEMORY_SCOPE_AGENT);
    __syncthreads();
    if (F.tid == 0) { int t = 0; for (int e = 0; e < 16; ++e) { tb[e] = t; t += (ne[e] + 255) >> 8; } tb[16] = t; }
    __syncthreads();
}
DI int moe_tile_expert(const LAS int* tb, int m) { int e = 0;
#pragma unroll
    for (int k = 1; k < 16; ++k) e += (m >= tb[k]) ? 1 : 0;
    return e; }
struct SchedMoeUp {
    int G, c; const char* H; const char* W; const LAS int* tb;
    static constexpr int NSH = (TC / 256) * 2;
    DI bool next(int i, Unit& u) const {
        const long L = (long)i * G + c;
        if (L < NSH) { u.pm = (int)(L >> 1); u.pn = (int)(L & 1); u.aux = 16; u.pa = H; u.pb = W + (size_t)16 * (512 * 1024 * 2) + (size_t)u.pn * (256 * 1024 * 2); return true; }
        const int r = (int)(L - NSH), m = r >> 1;
        if (m >= tb[16]) return false;
        const int e = moe_tile_expert(tb, m); u.pm = TC / 256 + m; u.pn = r & 1; u.aux = e;
        u.pa = H; u.pb = W + (size_t)e * (512 * 1024 * 2) + (size_t)u.pn * (256 * 1024 * 2); return true;
    }
};
DI void moe_fill_rows(const Frame& F, const SchedMoeUp& S) {
    LAS int* rows = (LAS int*)(F.lds + ROWS_OFF); const LAS int* ne = (const LAS int*)(F.lds + MOET_OFF); const LAS int* tb = ne + 16;
    const int* LIST = (const int*)(F.ws + WS_LIST);
    for (int i = 0; i < 12; ++i) {
        const long L = (long)i * S.G + S.c;
        if (L < SchedMoeUp::NSH) { if (F.tid < 256) rows[i * 256 + F.tid] = (int)(L >> 1) * 256 + F.tid; continue; }
        const int m = (int)(L - SchedMoeUp::NSH) >> 1; if (m >= tb[16]) break;
        const int e = moe_tile_expert(tb, m), idx = (m - tb[e]) * 256 + F.tid;
        if (F.tid < 256) rows[i * 256 + F.tid] = (idx < ne[e]) ? LIST[e * TC + idx] : 0;
    }
    __syncthreads();
}
struct SchedMoeDn {
    int G, c; const char* HID; const char* W; const LAS int* tb;
    DI bool next(int i, Unit& u) const {
        const long L = (long)i * G + c; const int m = (int)(L >> 2);
        if (m >= tb[16]) return false;
        const int e = moe_tile_expert(tb, m); u.pm = m; u.pn = (int)(L & 3); u.aux = e;
        u.pa = HID + (size_t)(TC + m * 256) * 512; u.pb = W + (size_t)e * (1024 * 256 * 2) + (size_t)u.pn * (256 * 256 * 2); return true;
    }
};

#ifndef ONLY_PH
#define ONLY_PH -1
#endif
#define ONLY_PH_P0 (ONLY_PH < 0 || ONLY_PH == 0)
enum { PH_NORM1 = 1, PH_INPROJ, PH_PREP1, PH_MLAG, PH_PREP2, PH_ATTN, PH_BRANCH, PH_OUT, PH_NORM2, PH_ROUTE, PH_MOEUP, PH_MOEDN, PH_MOEOUT, PH_END };

DI bool launder(Frame& F, unsigned char*& ws, unsigned char* wsa) {
    int w_ = F.wave; asm volatile("" : "+s"(w_));
    int l_ = (int)__builtin_amdgcn_mbcnt_hi(~0u, __builtin_amdgcn_mbcnt_lo(~0u, 0u)); asm volatile("" : "+v"(l_));
    F.lane = l_; F.tid = w_ * 64 + l_;
    asm volatile("" : "+s"(wsa)); ws = wsa; F.ws = wsa; return true; }


#ifndef PROBE_DOUBLE
#define PROBE_DOUBLE 0
#endif
struct Ctx { const float* xin; float* xout; const float* modl; int chunk, layer; };
#define SITE(name) DI void name(Frame& F, const Args& args, unsigned char* ws, const Ctx& C)
SITE(site_norm1) { norm_phase<false>(F, args, C.xin, (const bf16*)(ws + WS_XB), C.chunk, C.layer); }
SITE(site_inproj) {
    {
        SchedDense Sd; Sd.init(TC / 256, PG / 256, F.G, F.bx, ws + WS_H, (size_t)256 * 1024 * 2, ws + WS_WIN + (size_t)C.layer * NP * 1024 * 2, (size_t)256 * 1024 * 2);
        EpiStore E{(bf16*)(ws + WS_PROJ), PS, 1 << 30, 1.0f};
        pg8::gemm_phase(F.lds, F.tid, 1024, 1024, 1024, Sd, E); }
    g8::gate_gemm_fp8(F.lds, F.tid, F.G, F.bx, ws + WS_H8, ws + WS_WIN + ((size_t)C.layer * NP + PG) * 1024 * 2, (bf16*)(ws + WS_GT), 1.0f / WG8_SCALE, TC / 256, ((TC / 256) * (PG / 256)) % F.G);
}
SITE(site_prep1) { prep1_phase(F, args, C.chunk, C.layer); }
SITE(site_mlag) {
    SchedDense Sd; Sd.init(TC / 256, 4, F.G, F.bx, ws + WS_PROJ + PC_CQ * 2, (size_t)256 * PS * 2, ws + WS_WMLA + (size_t)C.layer * 1024 * 384 * 2, (size_t)256 * 384 * 2);
    EpiStore E{(bf16*)(ws + WS_QKVC), 1024, 1 << 30, 1.0f};
    pg8::gemm_phase(F.lds, F.tid, PS, 384, 384, Sd, E); }
SITE(site_prep2) { prep2_phase(F, args, C.layer); }
SITE(site_attn) { att::attn_phase(F, args, C.layer); }
SITE(site_branch) {
    SchedBranch Sb{(TC / 256) * 4, F.G, F.bx, (const char*)(ws + WS_O), (const char*)(ws + WS_WBR + (size_t)C.layer * 4 * 1024 * 256 * 2)};
    EpiGateChain E{(const bf16*)(ws + WS_GT), (bf16*)(ws + WS_MG)};
    pg8::gemm_phase(F.lds, F.tid, 1024, 256, 256, Sb, E); }
SITE(site_out) {
    SchedDense Sd; Sd.init(TC / 256, 4, F.G, F.bx, ws + WS_MG, (size_t)256 * 1024 * 2, ws + WS_WOUT + (size_t)C.layer * 1024 * 1024 * 2, (size_t)256 * 1024 * 2);
    EpiResGate E{C.xin, (const bf16*)(ws + WS_XB), (bf16*)(ws + WS_XB), C.modl + 2048};
    pg8::gemm_phase(F.lds, F.tid, 1024, 1024, 1024, Sd, E); }
SITE(site_norm2) { norm_phase<true>(F, args, nullptr, (const bf16*)(ws + WS_XB), C.chunk, C.layer); }
SITE(site_moeup) {
    moe_tables(F, C.chunk * NL + C.layer);
    SchedMoeUp Sm{F.G, F.bx, (const char*)(ws + WS_H), (const char*)(ws + WS_WGU + (size_t)C.layer * NEXP1 * 512 * 1024 * 2), (const LAS int*)(F.lds + MOET_OFF) + 16};
    moe_fill_rows(F, Sm);
    EpiSwiGLU E{(bf16*)(ws + WS_HID)};
    pg8::gemm_phase<EpiSwiGLU, SchedMoeUp, true>(F.lds, F.tid, 1024, 1024, 1024, Sm, E, (const LAS int*)(F.lds + ROWS_OFF)); }
SITE(site_moedn) {
    moe_tables(F, C.chunk * NL + C.layer);
    SchedMoeDn Sm{F.G, F.bx, (const char*)(ws + WS_HID), (const char*)(ws + WS_WD + (size_t)C.layer * NEXP1 * 1024 * 256 * 2), (const LAS int*)(F.lds + MOET_OFF) + 16};
    EpiStore E{(bf16*)(ws + WS_YBUF), 1024, 1 << 30, 1.0f};
    pg8::gemm_phase(F.lds, F.tid, 256, 256, 256, Sm, E); }
SITE(site_moeout) {
    moe_tables(F, C.chunk * NL + C.layer);
    SchedDense Sd; Sd.init(TC / 256, 4, F.G, F.bx, ws + WS_HID, (size_t)256 * 256 * 2, ws + WS_WD + ((size_t)C.layer * NEXP1 + 16) * 1024 * 256 * 2, (size_t)256 * 256 * 2);
    EpiMoeOut E{(const bf16*)(ws + WS_XB), (bf16*)(ws + WS_XB), (C.layer == NL - 1) ? C.xout : nullptr, C.modl + 5120, (const bf16*)(ws + WS_YBUF), (const int*)(ws + WS_TOKPOS), (const float*)(ws + WS_TOKW), (const LAS int*)(F.lds + MOET_OFF) + 16};
    pg8::gemm_phase(F.lds, F.tid, 256, 256, 256, Sd, E); }

template <int DUMMY>
DI void layer_body(Frame& F, const Args& args, unsigned char*& ws, const XcdBarrier& bar, const int chunk, const int layer) {
#define GRID_BAR() do { if (args.one) xcd_barrier(bar); } while (0)
#define IN(k) ((ONLY_PH < 0 || ONLY_PH == (k)) && args.ph_lo <= (k) && (k) < args.ph_hi && launder(F, ws, args.ws))
#define RUN(k, fn) do { if (IN(k)) { fn(F, args, ws, C); GRID_BAR(); } if (((PROBE_DOUBLE >> (k)) & 1) && IN(k)) { fn(F, args, ws, C); GRID_BAR(); } } while (0)
    Ctx C; C.chunk = chunk; C.layer = layer;
    C.xout = args.out + (size_t)chunk * TC * D;
    C.xin = (layer == 0) ? inp(F, 0) + (size_t)chunk * TC * D : nullptr;
    C.modl = (const float*)(args.ws + WS_MOD) + ((size_t)layer * NB + chunk * NBC) * 6144;
    RUN(PH_NORM1, site_norm1); RUN(PH_INPROJ, site_inproj); RUN(PH_PREP1, site_prep1); RUN(PH_MLAG, site_mlag); RUN(PH_PREP2, site_prep2); RUN(PH_ATTN, site_attn);
    RUN(PH_BRANCH, site_branch); RUN(PH_OUT, site_out); RUN(PH_NORM2, site_norm2); RUN(PH_MOEUP, site_moeup); RUN(PH_MOEDN, site_moedn); RUN(PH_MOEOUT, site_moeout);
#undef RUN
#undef IN
#undef GRID_BAR
}
__global__ void __launch_bounds__(NTHREADS, 2) trunk_fwd(Args args) {
    extern __shared__ __attribute__((aligned(16))) unsigned char lds_raw[];
    Frame F;
    F.lds = (LAS unsigned char*)lds_raw;
    F.tid = threadIdx.x; F.lane = F.tid & 63; F.wave = __builtin_amdgcn_readfirstlane(F.tid >> 6);
    F.G = gridDim.x; F.bx = blockIdx.x; F.ws = args.ws;
    unsigned char* ws = args.ws;
    gu32* ctl = (gu32*)(ws + WS_CTL);
    volatile LAS unsigned* MISC = (volatile LAS unsigned*)(F.lds + MISC_OFF);
    for (int u = F.tid; u < (LDS_BYTES - RING_BYTES) / 4; u += NTHREADS) ((LAS unsigned*)(F.lds + RING_BYTES))[u] = 0u;
    __syncthreads();
    if (F.tid == 0) {
#pragma unroll
        for (int k = 0; k < 30; ++k) ((volatile LAS unsigned long long*)(F.lds + PTAB_OFF))[k] = (unsigned long long)args.in[k];
    }
    __syncthreads();
    XcdBarrier bar; bar.bar = (unsigned*)(ctl + CW_BAR); bar.x = 0; bar.st = nullptr;
    if (args.one) bar = xcd_barrier_post((unsigned*)(ctl + CW_BAR), MISC + 8);
#define GRID_BAR() do { if (args.one) xcd_barrier(bar); } while (0)

    if ((ONLY_PH_P0) && args.ph_lo <= 0) { p0_prologue(F, args); GRID_BAR(); }
    if ((PROBE_DOUBLE & 1) && args.ph_lo <= 0) { launder(F, ws, args.ws); p0_prologue(F, args); GRID_BAR(); }

#if MK_MULTI
    layer_body<0>(F, args, ws, bar, args.c_lo, args.l_lo);
#else
    layer_body<0>(F, args, ws, bar, 0, 0); layer_body<1>(F, args, ws, bar, 0, 1); layer_body<2>(F, args, ws, bar, 0, 2); layer_body<3>(F, args, ws, bar, 0, 3);
    layer_body<4>(F, args, ws, bar, 1, 0); layer_body<5>(F, args, ws, bar, 1, 1); layer_body<6>(F, args, ws, bar, 1, 2); layer_body<7>(F, args, ws, bar, 1, 3);
#endif
}

extern "C" void kernel_launch(void* const* d_in, const int* in_sizes, int n_in, void* d_out, int out_size, void* d_ws, size_t ws_size, hipStream_t stream) {
    static int grid = 0;
    if (grid == 0) {
        if (n_in != 30 || in_sizes[0] != NB * S * D || out_size != NB * S * D || ws_size < WS_END) { fprintf(stderr, "kernel_launch: unexpected shapes / workspace (n_in %d, ws %zu)\n", n_in, ws_size); grid = -1; return; }
        int dev = 0, cus = 0, per_cu = 0;
        if (hipGetDevice(&dev) != hipSuccess || hipDeviceGetAttribute(&cus, hipDeviceAttributeMultiprocessorCount, dev) != hipSuccess) { grid = -1; return; }
        if (hipFuncSetAttribute((const void*)trunk_fwd, hipFuncAttributeMaxDynamicSharedMemorySize, LDS_BYTES) != hipSuccess) { fprintf(stderr, "kernel_launch: hipFuncSetAttribute failed\n"); grid = -1; return; }
        if (hipOccupancyMaxActiveBlocksPerMultiprocessor(&per_cu, (const void*)trunk_fwd, NTHREADS, LDS_BYTES) != hipSuccess || per_cu < 1) fprintf(stderr, "kernel_launch: occupancy query reports %d\n", per_cu);
        (void)hipGetLastError();
        grid = cus;
    }
    if (grid < 0) return;
    (void)hipMemsetAsync((char*)d_ws + WS_CTL, 0, CTL_ZERO_BYTES, stream);
    Args a{};
    for (int i = 0; i < 30; ++i) a.in[i] = (const float*)d_in[i];
    a.out = (float*)d_out; a.ws = (unsigned char*)d_ws;
#if MK_MULTI
    a.one = 0;
    a.c_lo = 0; a.c_hi = 0; a.l_lo = 0; a.l_hi = 0; a.ph_lo = 0; a.ph_hi = 1;
    hipLaunchKernelGGL(trunk_fwd, dim3(grid), dim3(NTHREADS), LDS_BYTES, stream, a);
    for (int c = 0; c < NCHUNK; ++c) for (int l = 0; l < NL; ++l) for (int ph = 1; ph < PH_END; ++ph) {
        a.c_lo = c; a.c_hi = c + 1; a.l_lo = l; a.l_hi = l + 1; a.ph_lo = ph; a.ph_hi = ph + 1;
        hipLaunchKernelGGL(trunk_fwd, dim3(grid), dim3(NTHREADS), LDS_BYTES, stream, a);
    }
#else
    a.one = 1; a.c_lo = 0; a.c_hi = NCHUNK; a.l_lo = 0; a.l_hi = NL; a.ph_lo = 0; a.ph_hi = PH_END;
    hipLaunchKernelGGL(trunk_fwd, dim3(grid), dim3(NTHREADS), LDS_BYTES, stream, a);
#endif
}
```

```cpp
#include <hip/hip_runtime.h>
#include <cstdio>
#include <cstdint>

#define GAS __attribute__((address_space(1)))
#define LAS __attribute__((address_space(3)))
typedef unsigned short bf16;
typedef unsigned v4u __attribute__((ext_vector_type(4)));
typedef unsigned v2u __attribute__((ext_vector_type(2)));
typedef float f32x2 __attribute__((ext_vector_type(2)));
typedef float f32x4 __attribute__((ext_vector_type(4)));
typedef float f32x16 __attribute__((ext_vector_type(16)));
typedef short bf16x8 __attribute__((ext_vector_type(8)));
typedef short s16x4 __attribute__((ext_vector_type(4)));
typedef GAS unsigned gu32;
#define RLX_AGENT __ATOMIC_RELAXED, __HIP_MEMORY_SCOPE_AGENT
#define DI __device__ __forceinline__

DI unsigned cvt_pk_bf16(float lo, float hi) { unsigned r; asm volatile("v_cvt_pk_bf16_f32 %0, %1, %2" : "=v"(r) : "v"(lo), "v"(hi)); return r; }
DI float bf_lo(unsigned u) { return __uint_as_float(u << 16); }
DI float bf_hi(unsigned u) { return __uint_as_float(u & 0xffff0000u); }
DI float bf2f(bf16 b) { return __uint_as_float(((unsigned)b) << 16); }
DI float fast_exp2(float x) { return __builtin_amdgcn_exp2f(x); }
DI float fast_log2(float x) { return __builtin_amdgcn_logf(x); }
DI float fast_rcp(float x) { return __builtin_amdgcn_rcpf(x); }
DI float sigmoid_f(float v) { return fast_rcp(1.0f + fast_exp2(-1.4426950408889634f * v)); }
DI unsigned pk4_fp8(float a, float b, float c, float d) { int p = 0; p = __builtin_amdgcn_cvt_pk_fp8_f32(a, b, p, false); p = __builtin_amdgcn_cvt_pk_fp8_f32(c, d, p, true); return (unsigned)p; }
DI f32x4 unpk4_fp8(unsigned u) { const f32x2 lo = __builtin_amdgcn_cvt_pk_f32_fp8((int)u, false), hi = __builtin_amdgcn_cvt_pk_f32_fp8((int)u, true); return (f32x4){lo.x, lo.y, hi.x, hi.y}; }
DI float wave_sum(float v) {
#pragma unroll
    for (int o = 1; o < 64; o <<= 1) v += __shfl_xor(v, o);
    return v;
}

namespace pg8 {
#define PG8_LAS __attribute__((address_space(3)))
typedef unsigned short bf16_t;
constexpr int BM = 256, BK = 64, HALF = 128, HTB = HALF * BK * 2, STAGE_BYTES = 8 * HTB;

__host__ __device__ __forceinline__ int lds_byte(int r, int c) { const int st = (r >> 4) * 2 + (c >> 5), rr = r & 15, cc = c & 31, ob = rr * 64 + cc * 2; return st * 1024 + (ob ^ (((ob >> 9) & 1) << 5)); }
__host__ __device__ __forceinline__ void stage_rc(int b, int& R, int& C) { const int st = b / 1024, sb = b % 1024, swz = sb ^ (((sb >> 9) & 1) << 5); R = (st >> 1) * 16 + swz / 64; C = (st & 1) * 32 + (swz % 64) / 2; }
__host__ __device__ __forceinline__ int perm32(int rho) { const int n = rho >> 4, i = rho & 15; return 8 * (i >> 2) + 4 * n + (i & 3); }

struct Unit { int pm, pn, aux; const char* pa; const char* pb; };
__device__ __forceinline__ const char* uni_ptr(const char* p) { const unsigned long long v = (unsigned long long)p; const unsigned lo = __builtin_amdgcn_readfirstlane((unsigned)v), hi = __builtin_amdgcn_readfirstlane((unsigned)(v >> 32)); return (const char*)(((unsigned long long)hi << 32) | lo); }

typedef f32x4 Acc[2][2][4][2];

template <class Epi, class Sched, bool GATHER = false>
__device__ __forceinline__ void gemm_phase(PG8_LAS unsigned char* lds, const int tid, const int lda, const int ldb, const int K, const Sched& S, const Epi& E, const PG8_LAS int* rows = nullptr) {
    const int wid = __builtin_amdgcn_readfirstlane(tid >> 6), lane = tid & 63, wr = wid >> 2, wc = wid & 3, fr = lane & 15, fq = lane >> 4;
    int nt = K / BK; asm volatile("" : "+s"(nt));
    unsigned voffA[2], voffB[2];
#pragma unroll
    for (int i = 0; i < 2; ++i) { int R, C; stage_rc(tid * 16 + i * 8192, R, C); const int Rb = Epi::PERM ? ((R & ~31) + perm32(R & 31)) : R;
        voffA[i] = (unsigned)(R * lda + C) * 2u; voffB[i] = (unsigned)(Rb * ldb + C) * 2u; }
    unsigned cvA[2][2], nvA[2][2];
#define PG8_GOFFS(dst, uidx) do { _Pragma("unroll") for (int _h = 0; _h < 2; ++_h) _Pragma("unroll") for (int _i = 0; _i < 2; ++_i) { int R_, C_; stage_rc(tid * 16 + _i * 8192, R_, C_); \
        dst[_h][_i] = (unsigned)(rows[(uidx) * 256 + _h * 128 + R_] * lda + C_) * 2u; } } while (0)
#define PG8_STAGE_A(bufoff, gbase, half, offs) do { if constexpr (GATHER) { PG8_STAGE(bufoff, gbase, offs[half]); } else { PG8_STAGE(bufoff, (gbase) + ((half) ? hstepA : 0), voffA); } } while (0)
    const size_t kstep = (size_t)(BK * 2);
    const size_t hstepA = (size_t)HALF * lda * 2, hstepB = (size_t)HALF * ldb * 2;
    const unsigned ldsw = (unsigned)wid * 1024u;
    const int aoff = lds_byte(wr * 64 + fr, fq * 8), boff = lds_byte(wc * 32 + fr, fq * 8);
#define PG8_SA(b, h) (((b) * 2 + (h)) * HTB)
#define PG8_SB(b, h) ((4 + (b) * 2 + (h)) * HTB)
#define PG8_STAGE(bufoff, gbase, voff) do { _Pragma("unroll") for (int _i = 0; _i < 2; ++_i) \
        __builtin_amdgcn_global_load_lds((const unsigned*)((const char*)(gbase) + (voff)[_i]), (PG8_LAS unsigned*)(lds + (bufoff) + ldsw + _i * 8192), 16, 0, 0); } while (0)
#define PG8_LDA(dst, b, h) do { _Pragma("unroll") for (int m = 0; m < 4; ++m) _Pragma("unroll") for (int k = 0; k < 2; ++k) dst[m][k] = *(const PG8_LAS bf16x8*)(lds + PG8_SA(b, h) + aoff + m * 2048 + k * 1024); } while (0)
#define PG8_LDB(dst, b, h) do { _Pragma("unroll") for (int n = 0; n < 2; ++n) _Pragma("unroll") for (int k = 0; k < 2; ++k) dst[n][k] = *(const PG8_LAS bf16x8*)(lds + PG8_SB(b, h) + boff + n * 2048 + k * 1024); } while (0)
#define PG8_MMA(ai, bj, At, Bt) do { __builtin_amdgcn_s_setprio(1); _Pragma("unroll") for (int m = 0; m < 4; ++m) _Pragma("unroll") for (int n = 0; n < 2; ++n) _Pragma("unroll") for (int k = 0; k < 2; ++k) \
        acc[ai][bj][m][n] = __builtin_amdgcn_mfma_f32_16x16x32_bf16(Bt[n][k], At[m][k], acc[ai][bj][m][n], 0, 0, 0); __builtin_amdgcn_s_setprio(0); } while (0)
#define PG8_WAIT_V(n) asm volatile("s_waitcnt vmcnt(" #n ")" ::: "memory")
#define PG8_WAIT_L(n) asm volatile("s_waitcnt lgkmcnt(" #n ")" ::: "memory")
#define PG8_BAR __builtin_amdgcn_s_barrier()
#define PG8_SCHED __builtin_amdgcn_sched_barrier(0)
    Unit cur, nxt; int ui = 0;
    if (!S.next(0, cur)) return;
    Acc acc;
#pragma unroll
    for (int a = 0; a < 2; ++a)
#pragma unroll
        for (int b = 0; b < 2; ++b)
#pragma unroll
            for (int m = 0; m < 4; ++m)
#pragma unroll
                for (int n = 0; n < 2; ++n) acc[a][b][m][n] = (f32x4){0.f, 0.f, 0.f, 0.f};
    bf16x8 At[4][2], B0[2][2], B1[2][2];
    const char* cA = cur.pa; const char* cB = cur.pb;
    if constexpr (GATHER) { PG8_GOFFS(cvA, 0); }
    PG8_STAGE(PG8_SB(0, 0), cB, voffB); PG8_STAGE(PG8_SB(0, 1), cB + hstepB, voffB); PG8_STAGE_A(PG8_SA(0, 0), cA, 0, cvA); PG8_STAGE_A(PG8_SA(0, 1), cA, 1, cvA);
    if (wr == 1) PG8_BAR;
    PG8_WAIT_V(2); PG8_BAR;
    PG8_STAGE(PG8_SB(1, 0), cB + kstep, voffB); PG8_STAGE_A(PG8_SA(1, 0), cA + kstep, 0, cvA); PG8_STAGE(PG8_SB(1, 1), cB + hstepB + kstep, voffB);
    PG8_WAIT_V(6); PG8_BAR;
    for (;;) {
        const bool has_next = S.next(ui + 1, nxt);
        const char* nA = has_next ? nxt.pa : cA; const char* nB = has_next ? nxt.pb : cB;
        if constexpr (GATHER) { if (has_next) { PG8_GOFFS(nvA, ui + 1); } else { _Pragma("unroll") for (int _h = 0; _h < 2; ++_h) _Pragma("unroll") for (int _i = 0; _i < 2; ++_i) nvA[_h][_i] = cvA[_h][_i]; } }
#pragma nounroll
        for (int t = 0; t < nt; t += 2) {
            const bool last = (t == nt - 2);
            const char* a1 = cA + (size_t)(t + 1) * kstep;
            const char* a2 = last ? nA : cA + (size_t)(t + 2) * kstep; const char* b2 = last ? nB : cB + (size_t)(t + 2) * kstep;
            const char* a3 = a2 + kstep; const char* b3 = b2 + kstep;
            PG8_LDB(B0, 0, 0); PG8_LDB(B1, 0, 1); PG8_SCHED; PG8_LDA(At, 0, 0); PG8_STAGE_A(PG8_SA(1, 1), a1, 1, cvA);
            PG8_WAIT_V(8); PG8_WAIT_L(0); PG8_BAR; PG8_MMA(0, 0, At, B0); PG8_MMA(0, 1, At, B1); PG8_BAR; PG8_SCHED;
            PG8_LDA(At, 0, 1); PG8_STAGE(PG8_SB(0, 0), b2, voffB); PG8_STAGE(PG8_SB(0, 1), b2 + hstepB, voffB); if (last) { PG8_STAGE_A(PG8_SA(0, 0), a2, 0, nvA); } else { PG8_STAGE_A(PG8_SA(0, 0), a2, 0, cvA); }
            PG8_WAIT_V(8); PG8_WAIT_L(0); PG8_BAR; PG8_MMA(1, 0, At, B0); PG8_MMA(1, 1, At, B1); PG8_BAR; PG8_SCHED;
            PG8_LDB(B0, 1, 0); PG8_LDB(B1, 1, 1); PG8_SCHED; PG8_LDA(At, 1, 0); if (last) { PG8_STAGE_A(PG8_SA(0, 1), a2, 1, nvA); } else { PG8_STAGE_A(PG8_SA(0, 1), a2, 1, cvA); }
            PG8_WAIT_V(8); PG8_WAIT_L(0); PG8_BAR; PG8_MMA(0, 0, At, B0); PG8_MMA(0, 1, At, B1); PG8_BAR; PG8_SCHED;
            PG8_LDA(At, 1, 1); PG8_STAGE(PG8_SB(1, 0), b3, voffB); PG8_STAGE(PG8_SB(1, 1), b3 + hstepB, voffB); if (last) { PG8_STAGE_A(PG8_SA(1, 0), a3, 0, nvA); } else { PG8_STAGE_A(PG8_SA(1, 0), a3, 0, cvA); }
            PG8_WAIT_V(8); PG8_WAIT_L(0); PG8_BAR; PG8_MMA(1, 0, At, B0); PG8_MMA(1, 1, At, B1); PG8_BAR; PG8_SCHED;
        }
        if (wr == 0) PG8_BAR;
        E(acc, cur, has_next, nxt, wr, wc, fr, fq);
        if (!has_next) break;
        if constexpr (!Epi::CHAIN) {
#pragma unroll
            for (int a = 0; a < 2; ++a)
#pragma unroll
                for (int b = 0; b < 2; ++b)
#pragma unroll
                    for (int m = 0; m < 4; ++m)
#pragma unroll
                        for (int n = 0; n < 2; ++n) acc[a][b][m][n] = (f32x4){0.f, 0.f, 0.f, 0.f};
        }
        cur = nxt; cA = nA; cB = nB; ++ui;
        if constexpr (GATHER) { _Pragma("unroll") for (int _h = 0; _h < 2; ++_h) _Pragma("unroll") for (int _i = 0; _i < 2; ++_i) cvA[_h][_i] = nvA[_h][_i]; }
        if (wr == 1) PG8_BAR;
    }
    PG8_WAIT_V(0);
    PG8_BAR;
#undef PG8_SA
#undef PG8_SB
#undef PG8_STAGE
#undef PG8_STAGE_A
#undef PG8_GOFFS
#undef PG8_LDA
#undef PG8_LDB
#undef PG8_MMA
#undef PG8_WAIT_V
#undef PG8_WAIT_L
#undef PG8_BAR
#undef PG8_SCHED
}
}

namespace g8 {
using pg8::lds_byte; using pg8::stage_rc; using pg8::perm32;
typedef int v4i_t __attribute__((ext_vector_type(4)));
typedef int v8i_t __attribute__((ext_vector_type(8)));
constexpr int HTB = 16384;
__device__ __forceinline__ void gate_gemm_fp8(LAS unsigned char* lds, const int tid, const int G, const int c, const unsigned char* A8, const unsigned char* B8, unsigned char* GT, const float scale, const int nMtiles, const int nheavy) {
    const int wid = __builtin_amdgcn_readfirstlane(tid >> 6), lane = tid & 63, wr = wid >> 2, wc = wid & 3, fr = lane & 15, fq = lane >> 4;
    constexpr int KB = 1024, NT = KB / 128;
    const bool deal79 = (G == 256 && nMtiles == 128 && nheavy == 128);
    const int gq = c >> 4;
    const int nun = deal79 ? (gq < 8 ? 7 : 9) : ((nMtiles * 16 > c) ? (nMtiles * 16 - c + G - 1) / G : 0);
    const int pm0 = deal79 ? (gq < 8 ? gq * 7 : 56 + (gq - 8) * 9) : 0;
    if (nun == 0) return;
    const int total = nun * NT;
    unsigned voffA, voffB;
    { int R, C; stage_rc(tid * 16, R, C); const int Rb = (R & ~31) + perm32(R & 31); voffA = (unsigned)(R * KB + 2 * C); voffB = (unsigned)(Rb * KB + 2 * C); }
    const unsigned ldsw = (unsigned)wid * 1024u;
    const int aoff = lds_byte(wr * 64 + fr, fq * 8), boff = lds_byte(wc * 32 + fr, fq * 8);
#define G8_DMA2(bufoff, gbase, o0) do { __builtin_amdgcn_global_load_lds((const unsigned*)((const char*)(gbase) + (o0)), (LAS unsigned*)(lds + (bufoff) + ldsw), 16, 0, 0); \
        __builtin_amdgcn_global_load_lds((const unsigned*)((const char*)(gbase) + ((o0) + 64u * KB)), (LAS unsigned*)(lds + (bufoff) + ldsw + 8192), 16, 0, 0); } while (0)
#define G8_ISSUE(s) do { const int u_ = (s) / NT, kt_ = (s) % NT, b_ = (s) & 1; const long L_ = (long)u_ * G + c; const int pm_ = deal79 ? pm0 + u_ : (int)(L_ >> 4), pn_ = deal79 ? (c & 15) : (int)(L_ & 15); \
        const unsigned char* pa_ = (const unsigned char*)pg8::uni_ptr((const char*)A8 + (size_t)pm_ * 256 * KB + kt_ * 128); const unsigned char* pb_ = (const unsigned char*)pg8::uni_ptr((const char*)B8 + (size_t)pn_ * 256 * KB + kt_ * 128); \
        G8_DMA2((b_ * 4 + 2) * HTB, pb_, voffB); G8_DMA2((b_ * 4 + 3) * HTB, pb_, voffB + 128u * KB); G8_DMA2((b_ * 4 + 0) * HTB, pa_, voffA); G8_DMA2((b_ * 4 + 1) * HTB, pa_, voffA + 128u * KB); } while (0)
#define G8_RD(off) (*(const LAS bf16x8*)(lds + (off)))
#define G8_CAT(x, y) __builtin_shufflevector(__builtin_bit_cast(v4i_t, (x)), __builtin_bit_cast(v4i_t, (y)), 0, 1, 2, 3, 4, 5, 6, 7)
#define G8_MMA(ai, A8f) do { __builtin_amdgcn_s_setprio(1); _Pragma("unroll") for (int m = 0; m < 4; ++m) _Pragma("unroll") for (int n = 0; n < 2; ++n) { \
        acc[ai][0][m][n] = __builtin_amdgcn_mfma_scale_f32_16x16x128_f8f6f4(B0f[n], A8f[m], acc[ai][0][m][n], 0, 0, 0, 0, 0, 0); \
        acc[ai][1][m][n] = __builtin_amdgcn_mfma_scale_f32_16x16x128_f8f6f4(B1f[n], A8f[m], acc[ai][1][m][n], 0, 0, 0, 0, 0, 0); } __builtin_amdgcn_s_setprio(0); } while (0)
    f32x4 acc[2][2][4][2];
#pragma unroll
    for (int a = 0; a < 2; ++a)
#pragma unroll
        for (int b = 0; b < 2; ++b)
#pragma unroll
            for (int m = 0; m < 4; ++m)
#pragma unroll
                for (int n = 0; n < 2; ++n) acc[a][b][m][n] = (f32x4){0.f, 0.f, 0.f, 0.f};
    G8_ISSUE(0);
    if (total > 1) G8_ISSUE(1);
#pragma nounroll
    for (int s = 0; s < total; ++s) {
        const int b = s & 1;
        if (s + 1 < total && (s % NT) != 0) asm volatile("s_waitcnt vmcnt(8)" ::: "memory"); else asm volatile("s_waitcnt vmcnt(0)" ::: "memory");
        __builtin_amdgcn_s_barrier();
        asm volatile("" ::: "memory");
        v8i_t A8f[4], A8g[4], B0f[2], B1f[2];
        { const int ab = (b * 4) * HTB + aoff, bb = (b * 4 + 2) * HTB + boff;
#pragma unroll
          for (int n = 0; n < 2; ++n) { B0f[n] = G8_CAT(G8_RD(bb + n * 2048), G8_RD(bb + n * 2048 + 1024)); B1f[n] = G8_CAT(G8_RD(bb + HTB + n * 2048), G8_RD(bb + HTB + n * 2048 + 1024)); }
#pragma unroll
          for (int m = 0; m < 4; ++m) { A8f[m] = G8_CAT(G8_RD(ab + m * 2048), G8_RD(ab + m * 2048 + 1024)); A8g[m] = G8_CAT(G8_RD(ab + HTB + m * 2048), G8_RD(ab + HTB + m * 2048 + 1024)); } }
        asm volatile("s_waitcnt lgkmcnt(0)" ::: "memory");
        __builtin_amdgcn_s_barrier();
        asm volatile("" ::: "memory");
        if (s + 2 < total) G8_ISSUE(s + 2);
        G8_MMA(0, A8f);
        G8_MMA(1, A8g);
        if ((s % NT) == NT - 1) {
            const int u_ = s / NT; const long L_ = (long)u_ * G + c; const int pm_ = __builtin_amdgcn_readfirstlane(deal79 ? pm0 + u_ : (int)(L_ >> 4)), pn_ = __builtin_amdgcn_readfirstlane(deal79 ? (c & 15) : (int)(L_ & 15));
            const int c4 = 64 * pn_ + 16 * wc + 4 * fq;
            const int pno = c4 >> 8, bjc = (c4 >> 7) & 1, wcc = (c4 >> 5) & 3, fqc = (c4 >> 3) & 3, half = (c4 >> 2) & 1;
            unsigned char* tp = GT + ((size_t)(pm_ * 4 + pno) * 65536) + (size_t)((wr * 4 + wcc) * 64 + fqc * 16 + fr) * 8 + half * 4;
            const size_t BR = (size_t)nMtiles * 4 * 65536;
#pragma unroll
            for (int ai = 0; ai < 2; ++ai)
#pragma unroll
                for (int m = 0; m < 4; ++m) {
                    f32x4 g[4];
#pragma unroll
                    for (int q = 0; q < 4; ++q) { const f32x4 z = acc[ai][q >> 1][m][q & 1] * scale; g[q] = (f32x4){sigmoid_f(z[0]), sigmoid_f(z[1]), sigmoid_f(z[2]), sigmoid_f(z[3])};
                        acc[ai][q >> 1][m][q & 1] = (f32x4){0.f, 0.f, 0.f, 0.f}; }
                    unsigned char* sp = tp + (size_t)(((ai * 4 + m) * 2 + bjc) * 512) * 8;
#pragma unroll
                    for (int q = 0; q < 4; ++q) { f32x4 r = g[q];
                        if (q < 3) {
#pragma unroll
                            for (int k = 0; k < 4; ++k) r[k] = g[q][k] * fast_rcp(fmaxf(g[q + 1][k], 1e-20f)); }
                        r = __builtin_elementwise_min(r, (f32x4){448.f, 448.f, 448.f, 448.f}); *(unsigned*)(sp + q * BR) = pk4_fp8(r[0], r[1], r[2], r[3]); }
                }
        }
    }
    asm volatile("s_waitcnt vmcnt(0)" ::: "memory");
    __builtin_amdgcn_s_barrier();
#undef G8_DMA2
#undef G8_ISSUE
#undef G8_RD
#undef G8_CAT
#undef G8_MMA
}
}
#define XB_TMO      128
#define XB_XCNT(j)  (256  + 64 * (j))
#define XB_XSUB(j)  (1280 + 64 * (j))
#define XB_XGEN(j)  (2304 + 64 * (j))
#define XB_TOP      3328
#define XB_TOPGEN   3392
#define XCD_BAR_WORDS 3456
#define XB_SPIN_CAP (1u << 18)

__device__ __forceinline__ unsigned xb_ld(unsigned* p)              { return __hip_atomic_load(p, __ATOMIC_RELAXED, __HIP_MEMORY_SCOPE_AGENT); }
__device__ __forceinline__ unsigned xb_add(unsigned* p, unsigned v) { return __hip_atomic_fetch_add(p, v, __ATOMIC_RELAXED, __HIP_MEMORY_SCOPE_AGENT); }
__device__ __forceinline__ unsigned xb_xcc_id() { return (unsigned)__builtin_amdgcn_s_getreg((3 << 11) | 20) & 0xFu; }
#define XB_SPIN(cond, bar) do { unsigned _sp = 0; while (cond) { __builtin_amdgcn_s_sleep(1); \
    if ((++_sp & 255u) == 0u) { if (xb_ld(&(bar)[XB_TMO])) break; if (_sp > XB_SPIN_CAP) { atomicAdd(&(bar)[XB_TMO], 1u); break; } } } } while (0)

struct XcdBarrier {
    unsigned* bar; unsigned x;
    volatile LAS unsigned* st;
};

__device__ __forceinline__ XcdBarrier xcd_barrier_post(unsigned* bar, volatile LAS unsigned* st) {
    XcdBarrier b; b.bar = bar; b.x = xb_xcc_id(); b.st = st;
    if (threadIdx.x == 0) (void)xb_add(&bar[XB_XCNT(b.x)], 1u);
    return b;
}
__device__ __forceinline__ void xcd_barrier_complete(unsigned* bar, unsigned x, unsigned& nloc, unsigned& nx) {
    const unsigned G = gridDim.x * gridDim.y * gridDim.z;
    unsigned sum, cnt, mine, sp = 0u;
    for (;;) {
        sum = 0u; cnt = 0u; mine = 0u;
#pragma unroll
        for (unsigned j = 0; j < 16; ++j) { const unsigned c = xb_ld(&bar[XB_XCNT(j)]); sum += c; cnt += (c > 0u) ? 1u : 0u; mine = (j == x) ? c : mine; }
        if (sum == G) break;
        __builtin_amdgcn_s_sleep(1);
        if ((++sp & 255u) == 0u) { if (xb_ld(&bar[XB_TMO])) break; if (sp > XB_SPIN_CAP) { atomicAdd(&bar[XB_TMO], 1u); break; } }
    }
    nloc = mine > 0u ? mine : 1u; nx = cnt > 0u ? cnt : 1u;
}

__device__ __forceinline__ void xcd_barrier(const XcdBarrier& b) {
    asm volatile("s_waitcnt vmcnt(0)" ::: "memory");
    __syncthreads();
    if (threadIdx.x == 0) {
        unsigned* bar = b.bar;
        __builtin_amdgcn_s_waitcnt(0);
        unsigned nloc = b.st[0], nx = b.st[1];
        if (nloc == 0u) { xcd_barrier_complete(bar, b.x, nloc, nx); b.st[0] = nloc; b.st[1] = nx; }
        const unsigned old = xb_add(&bar[XB_XSUB(b.x)], 1u);
        const unsigned gen = old / nloc;
        if (old + 1u == (gen + 1u) * nloc) {
            __builtin_amdgcn_fence(__ATOMIC_RELEASE, "agent");
            asm volatile("s_waitcnt vmcnt(0)" ::: "memory");
            const unsigned og = xb_add(&bar[XB_TOP], 1u);
            const unsigned tg = og / nx;
            if (og + 1u == (tg + 1u) * nx) xb_add(&bar[XB_TOPGEN], 1u);
            else XB_SPIN(xb_ld(&bar[XB_TOPGEN]) == tg, bar);
            __builtin_amdgcn_fence(__ATOMIC_ACQUIRE, "agent");
            xb_add(&bar[XB_XGEN(b.x)], 1u);
            asm volatile("s_waitcnt vmcnt(0)" ::: "memory");
        } else {
            XB_SPIN(xb_ld(&bar[XB_XGEN(b.x)]) == gen, bar);
            __builtin_amdgcn_fence(__ATOMIC_ACQUIRE, "agent");
            asm volatile("s_waitcnt vmcnt(0)" ::: "memory");
        }
    }
    __syncthreads();
}

constexpr int NB = 32, S = 2048, D = 1024, NL = 4;
constexpr int NBC = 16;
constexpr int NCHUNK = NB / NBC;
constexpr int TC = NBC * S;
constexpr int NP = 6912;
constexpr int PS = 2816;
constexpr int IN_COLS = 6820;
constexpr int PA_Q = 0, PA_K = 256, PA_V = 512, PB_Q = 768, PB_K = 1024, PB_V = 1280, PD_Q = 1536, PD_K = 1792, PD_V = 2048;
constexpr int PC_CQ = 2304, PC_CKV = 2560, PC_KR = 2688, PC_FA = 2720, PG = 2816;
constexpr int NEXP = 16, NEXP1 = 17;
constexpr int RPAD = 2 * TC + 4096;
constexpr float LOG2E = 1.4426950408889634f;
constexpr float EPS = 1e-6f;

constexpr size_t MiB = 1u << 20, KiB = 1u << 10;
constexpr size_t WS_CTL = 0, CTL_ZERO_BYTES = 1 * MiB;
constexpr size_t WS_MOD = 1 * MiB;
constexpr size_t WS_TOKE = 4 * MiB;
constexpr size_t WS_TOKW = WS_TOKE + 256 * KiB;
constexpr size_t WS_TOKPOS = WS_TOKW + 256 * KiB;
constexpr size_t WS_CNT = WS_TOKPOS + 256 * KiB;
constexpr size_t WS_TILEEXP = WS_CNT + 32 * KiB;
constexpr size_t WS_LOGF = 5 * MiB;
constexpr size_t WS_ROPE = 6 * MiB;
constexpr size_t WS_LIST = 10 * MiB;
constexpr size_t WS_WIN = 12 * MiB;
constexpr size_t WS_WMLA = 66 * MiB;
constexpr size_t WS_WBR = 69 * MiB;
constexpr size_t WS_WOUT = 77 * MiB;
constexpr size_t WS_WGU = 85 * MiB;
constexpr size_t WS_WD = 153 * MiB;
constexpr size_t WS_H = 187 * MiB;
constexpr size_t WS_O = 251 * MiB;
constexpr size_t WS_MG = 315 * MiB;
constexpr size_t WS_QKVC = 379 * MiB;
constexpr size_t WS_QC = 443 * MiB;
constexpr size_t WS_KC = 467 * MiB;
constexpr size_t WS_PROJ = 491 * MiB;
constexpr size_t WS_GT = 667 * MiB;
constexpr size_t WS_HS = 491 * MiB;
constexpr size_t WS_HID = 627 * MiB;
constexpr size_t WS_YBUF = 677 * MiB;
constexpr size_t WS_XB = 923 * MiB;
constexpr size_t WS_H8 = 987 * MiB;
constexpr size_t WS_END = 1019 * MiB;
constexpr float WG8_SCALE = 64.0f;
static_assert(WS_PROJ + (size_t)TC * PS * 2 <= WS_GT && WS_GT + (size_t)4 * TC * 1024 * 2 <= WS_XB && WS_PROJ + (size_t)TC * PS * 2 <= WS_END && WS_HS + (size_t)RPAD * 1024 * 2 <= WS_HID && WS_HID + (size_t)(TC + RPAD) * 256 * 2 <= WS_YBUF && WS_YBUF + (size_t)RPAD * 1024 * 2 <= WS_XB, "ws map");
static_assert(WS_WIN + (size_t)NL * NP * 1024 * 2 <= WS_WMLA && WS_WGU + (size_t)NL * NEXP1 * 512 * 1024 * 2 <= WS_WD && WS_WD + (size_t)NL * NEXP1 * 1024 * 256 * 2 <= WS_H, "ws map 2");
constexpr int CW_TMO = 0, CW_BAR = 4096, CW_GCNT = 16384;
constexpr int NMT_WORD = 1000;

constexpr int RING_BYTES = 131072;
constexpr int MISC_OFF = RING_BYTES + 320;
constexpr int LDS_BYTES = 147456;
constexpr int NWAVES = 8, NTHREADS = 512;

struct Args {
    const float* in[30]; float* out; unsigned char* ws;
    int c_lo, c_hi, l_lo, l_hi, ph_lo, ph_hi, one, pad;
};

struct Frame {
    LAS unsigned char* lds;
    int tid, lane, wave, G, bx;
    unsigned char* ws;
};
constexpr int MOET_OFF = RING_BYTES + 1536;
constexpr int ROWS_OFF = RING_BYTES + 4096;
constexpr int PTAB_OFF = RING_BYTES + 1024;
DI const float* inp(const Frame& F, int k) {
    const unsigned long long v = ((volatile LAS unsigned long long*)(F.lds + PTAB_OFF))[k];
    const unsigned lo = __builtin_amdgcn_readfirstlane((unsigned)v), hi = __builtin_amdgcn_readfirstlane((unsigned)(v >> 32));
    return (const float*)(((unsigned long long)hi << 32) | lo);
}

struct MapIdent { int off; DI int operator()(int n) const { return off + n; } };
struct MapGate { int off; DI int operator()(int n) const { return (n >> 7) * 256 + off + (n & 127); } };
struct MapIn { DI int operator()(int s) const {
    if (s < 768) return s;
    if (s < 772) return PC_FA + (s - 768);
    if (s < 1540) return PB_Q + (s - 772);
    if (s < 1956) return PC_CQ + (s - 1540);
    if (s < 2724) return PD_Q + (s - 1956);
    return -1; } };

template <class Map> DI void tr_item(const float* W, int N, bf16* WT, int ldk, int koff, LAS float* scr, int k0, int n0, int lane, const Map map) {
    const int nn = n0 + (lane & 31);
    float tv[32];
#pragma unroll
    for (int i = 0; i < 32; ++i) { const int kk = 2 * i + (lane >> 5); tv[i] = (nn < N) ? W[(size_t)(k0 + kk) * N + nn] : 0.f; }
#pragma unroll
    for (int i = 0; i < 32; ++i) { const int kk = 2 * i + (lane >> 5); scr[kk * 33 + (lane & 31)] = tv[i]; }
    asm volatile("s_waitcnt lgkmcnt(0)" ::: "memory");
    const int c = lane & 7;
#pragma unroll
    for (int j = 0; j < 4; ++j) { const int nl = (lane >> 3) + 8 * j; const LAS float* s = scr + (8 * c) * 33 + nl;
        v4u o; o.x = cvt_pk_bf16(s[0 * 33], s[1 * 33]); o.y = cvt_pk_bf16(s[2 * 33], s[3 * 33]); o.z = cvt_pk_bf16(s[4 * 33], s[5 * 33]); o.w = cvt_pk_bf16(s[6 * 33], s[7 * 33]);
        const int dr = (n0 + nl < N) ? map(n0 + nl) : -1;
        if (dr >= 0) *(v4u*)(WT + (size_t)dr * ldk + koff + k0 + 8 * c) = o; }
    asm volatile("s_waitcnt lgkmcnt(0)" ::: "memory");
}

DI void tr_item8(const float* W, int N, unsigned char* WT8, int ldk, LAS float* scr, int k0, int n0, int nbase, int lane, float scale) {
    const int nn = n0 + (lane & 31);
    float tv[32];
#pragma unroll
    for (int i = 0; i < 32; ++i) { const int kk = 2 * i + (lane >> 5); tv[i] = (nn < N) ? W[(size_t)(k0 + kk) * N + nn] : 0.f; }
#pragma unroll
    for (int i = 0; i < 32; ++i) { const int kk = 2 * i + (lane >> 5); scr[kk * 33 + (lane & 31)] = tv[i] * scale; }
    asm volatile("s_waitcnt lgkmcnt(0)" ::: "memory");
    const int c = lane & 7;
#pragma unroll
    for (int j = 0; j < 4; ++j) { const int nl = (lane >> 3) + 8 * j; const LAS float* s = scr + (8 * c) * 33 + nl;
        v2u o; o.x = pk4_fp8(s[0 * 33], s[1 * 33], s[2 * 33], s[3 * 33]); o.y = pk4_fp8(s[4 * 33], s[5 * 33], s[6 * 33], s[7 * 33]);
        if (n0 + nl < N) { const int gi = n0 + nl - nbase, b = gi >> 10, cc = gi & 1023;
            const int row = (cc >> 6) * 256 + 128 * (b >> 1) + 32 * ((cc >> 4) & 3) + 8 * ((cc >> 2) & 3) + 4 * (b & 1) + (cc & 3);
            *(v2u*)(WT8 + (size_t)row * ldk + k0 + 8 * c) = o; } }
    asm volatile("s_waitcnt lgkmcnt(0)" ::: "memory");
}

constexpr int I_G8 = 16 * 128;
constexpr int I_IN = 16 * 214, I_UQ = 48, I_UKV = 32, I_BR = 512, I_OUT = 512, I_G = NEXP1 * 128, I_DN = NEXP1 * 128;
constexpr int NITEM_L = I_IN + I_UQ + I_UKV + I_BR + I_OUT + 2 * I_G + I_DN + I_G8;

DI void p0_prologue(const Frame& F, const Args& A) {
    unsigned char* ws = F.ws;
    {
        LAS float* condL = (LAS float*)F.lds;
        const float* c = inp(F, 1);
        for (int idx = F.tid; idx < NB * D; idx += NTHREADS) { const float v = c[idx]; const int b = idx >> 10, k = idx & 1023; condL[k * 32 + b] = v * sigmoid_f(v); }
        __syncthreads();
        const float* w_ada = inp(F, 5); const float* b_ada = inp(F, 6); float* MOD = (float*)(ws + WS_MOD);
        const int gw = F.bx * NWAVES + F.wave, NGW = F.G * NWAVES;
        for (int u = gw; u < NL * 384; u += NGW) {
            const int l = u / 384, j0 = (u % 384) * 16, col = F.lane & 15, ks = F.lane >> 4;
            float acc[32];
#pragma unroll
            for (int b = 0; b < 32; ++b) acc[b] = 0.f;
            const float* wp = w_ada + ((size_t)l * D + ks * 256) * 6144 + j0 + col;
#pragma unroll 16
            for (int k = 0; k < 256; ++k) {
                const float w = wp[(size_t)k * 6144];
                const LAS f32x4* cl = (const LAS f32x4*)(condL + (ks * 256 + k) * 32);
#pragma unroll
                for (int q = 0; q < 8; ++q) { const f32x4 cv = cl[q]; acc[4 * q] += w * cv.x; acc[4 * q + 1] += w * cv.y; acc[4 * q + 2] += w * cv.z; acc[4 * q + 3] += w * cv.w; }
            }
            const float bias = b_ada[l * 6144 + j0 + col];
#pragma unroll
            for (int b = 0; b < 32; ++b) { float v = acc[b]; v += __shfl_xor(v, 16); v += __shfl_xor(v, 32); if (ks == 0) MOD[((size_t)l * NB + b) * 6144 + j0 + col] = v + bias; }
        }
        __syncthreads();
    }
    {
        LAS float* scr = (LAS float*)(F.lds + F.wave * 16384);
        const int gw = F.bx * NWAVES + F.wave, NGW = F.G * NWAVES;
        bf16* WinT = (bf16*)(ws + WS_WIN); bf16* WmlaT = (bf16*)(ws + WS_WMLA); bf16* WbrT = (bf16*)(ws + WS_WBR); bf16* WoutT = (bf16*)(ws + WS_WOUT);
        bf16* WguT = (bf16*)(ws + WS_WGU); bf16* WdT = (bf16*)(ws + WS_WD);
        for (int it = gw; it < NL * NITEM_L; it += NGW) {
            const int l = it / NITEM_L; int r = it % NITEM_L;
            if (r < I_IN) { const int kb = r / 214, nb = r % 214; tr_item(inp(F, 7) + (size_t)l * D * IN_COLS, IN_COLS, WinT + (size_t)l * NP * 1024, 1024, 0, scr, 64 * kb, 32 * nb, F.lane, MapIn{}); continue; } r -= I_IN;
            if (r < I_UQ) { const int kb = r / 12, nb = r % 12; tr_item(inp(F, 13) + (size_t)l * 256 * 384, 384, WmlaT + (size_t)l * 1024 * 384, 384, 0, scr, 64 * kb, 32 * nb, F.lane, MapIdent{0}); continue; } r -= I_UQ;
            if (r < I_UKV) { const int kb = r / 16, nb = r % 16; tr_item(inp(F, 14) + (size_t)l * 128 * 512, 512, WmlaT + (size_t)l * 1024 * 384, 384, 256, scr, 64 * kb, 32 * nb, F.lane, MapIdent{384}); continue; } r -= I_UKV;
            if (r < I_BR) { const int b = r / 128, rr = r % 128, kb = rr / 32, nb = rr % 32; tr_item(inp(F, 20) + (size_t)(l * 4 + b) * 256 * 1024, 1024, WbrT + (size_t)(l * 4 + b) * 1024 * 256, 256, 0, scr, 64 * kb, 32 * nb, F.lane, MapIdent{0}); continue; } r -= I_BR;
            if (r < I_OUT) { const int kb = r / 32, nb = r % 32; tr_item(inp(F, 21) + (size_t)l * 1024 * 1024, 1024, WoutT + (size_t)l * 1024 * 1024, 1024, 0, scr, 64 * kb, 32 * nb, F.lane, MapIdent{0}); continue; } r -= I_OUT;
            if (r < I_G) { const int e = r / 128, rr = r % 128, kb = rr / 8, nb = rr % 8; const float* src = e < 16 ? inp(F, 24) + (size_t)(l * 16 + e) * 1024 * 256 : inp(F, 27) + (size_t)l * 1024 * 256;
                tr_item(src, 256, WguT + (size_t)(l * NEXP1 + e) * 512 * 1024, 1024, 0, scr, 64 * kb, 32 * nb, F.lane, MapGate{0}); continue; } r -= I_G;
            if (r < I_G) { const int e = r / 128, rr = r % 128, kb = rr / 8, nb = rr % 8; const float* src = e < 16 ? inp(F, 25) + (size_t)(l * 16 + e) * 1024 * 256 : inp(F, 28) + (size_t)l * 1024 * 256;
                tr_item(src, 256, WguT + (size_t)(l * NEXP1 + e) * 512 * 1024, 1024, 0, scr, 64 * kb, 32 * nb, F.lane, MapGate{128}); continue; } r -= I_G;
            if (r >= I_DN) { r -= I_DN; const int kb = r / 128, nb = r % 128;
                tr_item8(inp(F, 7) + (size_t)l * D * IN_COLS, IN_COLS, (unsigned char*)(WinT + ((size_t)l * NP + PG) * 1024), 1024, scr, 64 * kb, 2724 + 32 * nb, 2724, F.lane, WG8_SCALE); continue; }
            { const int e = r / 128, rr = r % 128, kb = rr / 32, nb = rr % 32; const float* src = e < 16 ? inp(F, 26) + (size_t)(l * 16 + e) * 256 * 1024 : inp(F, 29) + (size_t)l * 256 * 1024;
                tr_item(src, 1024, WdT + (size_t)(l * NEXP1 + e) * 1024 * 256, 256, 0, scr, 64 * kb, 32 * nb, F.lane, MapIdent{0}); }
        }
        const int gt = F.bx * NTHREADS + F.tid, NGT = F.G * NTHREADS;
        const v4u z = {0u, 0u, 0u, 0u};
        for (int p = gt; p < NL * 92 * 128; p += NGT) { const int l = p / (92 * 128), q = p % (92 * 128), row = 2724 + q / 128, kc = (q % 128) * 8; *(v4u*)(WinT + ((size_t)l * NP + row) * 1024 + kc) = z; }
        for (int p = gt; p < NL * 1024 * 48; p += NGT) { const int l = p / (1024 * 48), q = p % (1024 * 48), row = q / 48, kc = (q % 48) * 8;
            const bool zr = (row < 384 && kc >= 256) || (row >= 384 && row < 896 && kc < 256) || row >= 896;
            if (zr) *(v4u*)(WmlaT + ((size_t)l * 1024 + row) * 384 + kc) = z; }
    }
}

template <bool ROUTER>
DI void norm_phase(const Frame& F, const Args& A, const float* xs, const bf16* xb, int chunk, int layer) {
    unsigned char* ws = F.ws;
    bf16* H = (bf16*)(ws + WS_H);
    const float* gain = inp(F, ROUTER ? 4 : 3) + layer * D;
    const float* MOD = (const float*)(ws + WS_MOD) + (size_t)layer * NB * 6144;
    const int SH = ROUTER ? 3072 : 0, SC = ROUTER ? 4096 : 1024;
    LAS f32x4* RW = (LAS f32x4*)F.lds;
    LAS float* wscr = (LAS float*)(F.lds + 65536) + F.wave * 64;
    LAS int* cntL = (LAS int*)(F.lds + 65536 + 2048);
    LAS int* baseL = cntL + 16; LAS int* selL = cntL + 64;
    if (ROUTER) {
        const float* rw = inp(F, 22);
        for (int idx = F.tid; idx < 4 * 16 * 64; idx += NTHREADS) { const int ln = idx & 63, e = (idx >> 6) & 15, j = idx >> 10; const int col = 4 * ln + 256 * j;
            RW[idx] = (f32x4){rw[(col + 0) * 16 + e], rw[(col + 1) * 16 + e], rw[(col + 2) * 16 + e], rw[(col + 3) * 16 + e]}; }
        if (F.tid < 16) cntL[F.tid] = 0;
        __syncthreads();
    }
    for (int rb = F.bx; rb < TC / 128; rb += F.G) {
        const int r0 = rb * 128 + F.wave * 16;
        const int b = (chunk * TC + r0) / S;
        f32x4 gs[4], shv[4];
#pragma unroll
        for (int j = 0; j < 4; ++j) { const int col = 4 * F.lane + 256 * j; const f32x4 g = *(const f32x4*)(gain + col), sc = *(const f32x4*)(MOD + (size_t)b * 6144 + SC + col);
            gs[j] = g * (sc + 1.0f); shv[j] = *(const f32x4*)(MOD + (size_t)b * 6144 + SH + col); }
        for (int rq = 0; rq < 16; rq += 4) {
            f32x4 y[4][4];
#pragma unroll
            for (int rr = 0; rr < 4; ++rr) {
                const int row = r0 + rq + rr;
                float ss = 0.f;
                if (xs) { const f32x4* xr = (const f32x4*)(xs + (size_t)row * D) + F.lane;
#pragma unroll
                    for (int j = 0; j < 4; ++j) y[rr][j] = xr[64 * j]; }
                else { const v2u* xr = (const v2u*)(xb + (size_t)row * D) + F.lane;
#pragma unroll
                    for (int j = 0; j < 4; ++j) { const v2u r = xr[64 * j]; y[rr][j] = (f32x4){bf_lo(r.x), bf_hi(r.x), bf_lo(r.y), bf_hi(r.y)}; } }
#pragma unroll
                for (int j = 0; j < 4; ++j) { ss += (y[rr][j].x * y[rr][j].x + y[rr][j].y * y[rr][j].y) + (y[rr][j].z * y[rr][j].z + y[rr][j].w * y[rr][j].w); }
                const float rs = 1.0f / sqrtf(wave_sum(ss) * (1.0f / D) + EPS);
                unsigned long long* o8 = (unsigned long long*)(H + (size_t)row * D) + F.lane;
#pragma unroll
                for (int j = 0; j < 4; ++j) { y[rr][j] = y[rr][j] * rs * gs[j] + shv[j];
                    o8[64 * j] = (unsigned long long)cvt_pk_bf16(y[rr][j].x, y[rr][j].y) | ((unsigned long long)cvt_pk_bf16(y[rr][j].z, y[rr][j].w) << 32);
                    if (!ROUTER) { const f32x4 c = __builtin_elementwise_min(__builtin_elementwise_max(y[rr][j], (f32x4){-448.f, -448.f, -448.f, -448.f}), (f32x4){448.f, 448.f, 448.f, 448.f});
                        *(unsigned*)(ws + WS_H8 + (size_t)row * D + 4 * F.lane + 256 * j) = pk4_fp8(c.x, c.y, c.z, c.w); } }
            }
            if (ROUTER) {
                float v[64];
#pragma unroll
                for (int i = 0; i < 64; ++i) v[i] = 0.f;
#pragma unroll
                for (int j = 0; j < 4; ++j)
#pragma unroll
                    for (int e = 0; e < 16; ++e) { const f32x4 w = RW[(j * 16 + e) * 64 + F.lane];
#pragma unroll
                        for (int rr = 0; rr < 4; ++rr) v[rr * 16 + e] += (y[rr][j].x * w.x + y[rr][j].y * w.y) + (y[rr][j].z * w.z + y[rr][j].w * w.w); }
#pragma unroll
                for (int d = 32; d >= 1; d >>= 1) {
                    const bool up = (F.lane & d) != 0;
#pragma unroll
                    for (int k = 0; k < d; ++k) { const float send = up ? v[k] : v[k + d]; const float keep = up ? v[k + d] : v[k]; v[k] = keep + __shfl_xor(send, d); }
                }
                wscr[F.lane] = v[0];
                __builtin_amdgcn_wave_barrier();
                asm volatile("s_waitcnt lgkmcnt(0)" ::: "memory");
                float lg[16];
                { const LAS f32x4* p = (const LAS f32x4*)(wscr + (F.lane >> 4) * 16);
#pragma unroll
                  for (int q = 0; q < 4; ++q) { const f32x4 t = p[q]; lg[4 * q] = t.x; lg[4 * q + 1] = t.y; lg[4 * q + 2] = t.z; lg[4 * q + 3] = t.w; } }
                __builtin_amdgcn_wave_barrier();
                const float* rbias = inp(F, 23);
                float sc[16], sel[16];
#pragma unroll
                for (int e = 0; e < 16; ++e) { sc[e] = 1.0f / (1.0f + expf(-lg[e])); sel[e] = sc[e] + rbias[e]; }
                float gsc[4];
#pragma unroll
                for (int g = 0; g < 4; ++g) { const float a0 = sel[4 * g], a1 = sel[4 * g + 1], a2 = sel[4 * g + 2], a3 = sel[4 * g + 3];
                    const float h1 = fmaxf(a0, a1), l1 = fminf(a0, a1), h2 = fmaxf(a2, a3), l2 = fminf(a2, a3);
                    gsc[g] = fmaxf(h1, h2) + fmaxf(fminf(h1, h2), fmaxf(l1, l2)); }
                int grp = 0; float best = gsc[0];
#pragma unroll
                for (int g = 1; g < 4; ++g) if (gsc[g] > best) { best = gsc[g]; grp = g; }
                float a[4], s4[4];
#pragma unroll
                for (int k = 0; k < 4; ++k) { a[k] = sel[k]; s4[k] = sc[k]; }
#pragma unroll
                for (int g = 1; g < 4; ++g) if (grp == g) {
#pragma unroll
                    for (int k = 0; k < 4; ++k) { a[k] = sel[4 * g + k]; s4[k] = sc[4 * g + k]; } }
                int i1 = 0; float m1 = a[0];
#pragma unroll
                for (int k = 1; k < 4; ++k) if (a[k] > m1) { m1 = a[k]; i1 = k; }
                int i2 = -1; float m2 = -3.0e38f;
#pragma unroll
                for (int k = 0; k < 4; ++k) if (k != i1 && a[k] > m2) { m2 = a[k]; i2 = k; }
                float w1 = s4[0], w2 = s4[0];
#pragma unroll
                for (int k = 1; k < 4; ++k) { if (i1 == k) w1 = s4[k]; if (i2 == k) w2 = s4[k]; }
                const float inv = 1.0f / (w1 + w2);
                if ((F.lane & 15) == 0) {
                    const int tl = F.wave * 16 + rq + (F.lane >> 4);
                    const int e1 = grp * 4 + i1, e2 = grp * 4 + i2;
                    float* tw = (float*)(ws + WS_TOKW); const int row = rb * 128 + tl;
                    tw[row * 2] = w1 * inv; tw[row * 2 + 1] = w2 * inv;
                    const int k1 = __hip_atomic_fetch_add(cntL + e1, 1, __ATOMIC_RELAXED, __HIP_MEMORY_SCOPE_WORKGROUP), k2 = __hip_atomic_fetch_add(cntL + e2, 1, __ATOMIC_RELAXED, __HIP_MEMORY_SCOPE_WORKGROUP);
                    selL[tl * 2] = (e1 << 20) | k1; selL[tl * 2 + 1] = (e2 << 20) | k2;
                }
            }
        }
        if (ROUTER) {
            __syncthreads();
            if (F.tid < 16) { baseL[F.tid] = (int)__hip_atomic_fetch_add((unsigned*)(ws + WS_CTL) + CW_GCNT + 64 * (chunk * NL + layer) + F.tid, (unsigned)cntL[F.tid], __ATOMIC_RELAXED, __HIP_MEMORY_SCOPE_AGENT); }
            __syncthreads();
            if (F.tid < 256) { const int sv = selL[F.tid], e = sv >> 20, lp = baseL[e] + (sv & 0xfffff);
                ((int*)(ws + WS_LIST))[e * TC + lp] = rb * 128 + (F.tid >> 1); ((int*)(ws + WS_TOKPOS))[(rb * 128) * 2 + F.tid] = (e << 20) | lp; }
            __syncthreads();
            if (F.tid < 16) cntL[F.tid] = 0;
            __syncthreads();
        }
    }
}

DI float sum16(float v) { v += __shfl_xor(v, 1); v += __shfl_xor(v, 2); v += __shfl_xor(v, 4); v += __shfl_xor(v, 8); return v; }

DI void head_norm4(bf16* p, const f32x4 g, int lane) {
    const v2u raw = *(const v2u*)(p + 4 * lane);
    f32x4 f = {bf_lo(raw.x), bf_hi(raw.x), bf_lo(raw.y), bf_hi(raw.y)};
    const float ss = sum16((f.x * f.x + f.y * f.y) + (f.z * f.z + f.w * f.w));
    const float rs = 1.0f / sqrtf(ss * (1.0f / 64.0f) + EPS);
    f = f * rs * g;
    v2u o; o.x = cvt_pk_bf16(f.x, f.y); o.y = cvt_pk_bf16(f.z, f.w);
    *(v2u*)(p + 4 * lane) = o;
}

DI void prep1_phase(const Frame& F, const Args& A, int chunk, int layer) {
    unsigned char* ws = F.ws;
    bf16* PROJ = (bf16*)(ws + WS_PROJ);
    float* LOGF = (float*)(ws + WS_LOGF); float* ROPE = (float*)(ws + WS_ROPE);
    const int* positions = (const int*)inp(F, 2);
    const int lane = F.lane, d4 = (4 * lane) & 63;
    f32x4 gh[4];
    gh[0] = *(const f32x4*)(inp(F, 9) + layer * 64 + d4); gh[1] = *(const f32x4*)(inp(F, 10) + layer * 64 + d4);
    gh[2] = *(const f32x4*)(inp(F, 17) + layer * 64 + d4); gh[3] = *(const f32x4*)(inp(F, 18) + layer * 64 + d4);
    const f32x4 g_lq = *(const f32x4*)(inp(F, 11) + layer * 256 + 4 * lane);
    const f32x2 g_lkv = *(const f32x2*)(inp(F, 12) + layer * 128 + 2 * lane);
    const float fb = inp(F, 8)[layer * 4 + (lane & 3)];
    const float invf = exp2f(-(float)(lane & 15) * (13.287712379549449f / 16.0f));
    const int gw = F.bx * NWAVES + F.wave, NGW = F.G * NWAVES;
    constexpr int HOFF[4] = {PA_Q, PA_K, PD_Q, PD_K};
    for (int r0 = gw * 16; r0 < TC; r0 += NGW * 16) {
        for (int rq = 0; rq < 16; rq += 4) {
            v2u rh[4][4], rc[4]; unsigned rkv[4];
#pragma unroll
            for (int rr = 0; rr < 4; ++rr) { const bf16* pr = PROJ + (size_t)(r0 + rq + rr) * PS;
#pragma unroll
                for (int k = 0; k < 4; ++k) rh[rr][k] = *(const v2u*)(pr + HOFF[k] + 4 * lane);
                rc[rr] = *(const v2u*)(pr + PC_CQ + 4 * lane); rkv[rr] = *(const unsigned*)(pr + PC_CKV + 2 * lane); }
            const int rowl = r0 + rq + (lane >> 4), il = lane & 15; bf16* prl = PROJ + (size_t)rowl * PS;
            const float t1 = bf2f(prl[PC_KR + il]), t2 = bf2f(prl[PC_KR + 16 + il]);
            const float pos = (float)positions[(size_t)chunk * TC + rowl];
            const int rowf = r0 + rq + ((lane >> 2) & 3);
            const float fav = bf2f(PROJ[(size_t)rowf * PS + PC_FA + (lane & 3)]);
#pragma unroll
            for (int rr = 0; rr < 4; ++rr) { bf16* pr = PROJ + (size_t)(r0 + rq + rr) * PS;
                f32x4 f[4]; float ss[4];
#pragma unroll
                for (int k = 0; k < 4; ++k) { f[k] = (f32x4){bf_lo(rh[rr][k].x), bf_hi(rh[rr][k].x), bf_lo(rh[rr][k].y), bf_hi(rh[rr][k].y)}; ss[k] = (f[k].x * f[k].x + f[k].y * f[k].y) + (f[k].z * f[k].z + f[k].w * f[k].w); }
#pragma unroll
                for (int o = 1; o < 16; o <<= 1) {
#pragma unroll
                    for (int k = 0; k < 4; ++k) ss[k] += __shfl_xor(ss[k], o); }
#pragma unroll
                for (int k = 0; k < 4; ++k) { const float rs = 1.0f / sqrtf(ss[k] * (1.0f / 64.0f) + EPS); f[k] = f[k] * rs * gh[k];
                    v2u o; o.x = cvt_pk_bf16(f[k].x, f[k].y); o.y = cvt_pk_bf16(f[k].z, f[k].w); *(v2u*)(pr + HOFF[k] + 4 * lane) = o; }
            }
            {
                f32x4 fq[4]; float a[4], b[4], s1[4], s2[4];
#pragma unroll
                for (int rr = 0; rr < 4; ++rr) { fq[rr] = (f32x4){bf_lo(rc[rr].x), bf_hi(rc[rr].x), bf_lo(rc[rr].y), bf_hi(rc[rr].y)}; a[rr] = bf_lo(rkv[rr]); b[rr] = bf_hi(rkv[rr]);
                    s1[rr] = (fq[rr].x * fq[rr].x + fq[rr].y * fq[rr].y) + (fq[rr].z * fq[rr].z + fq[rr].w * fq[rr].w); s2[rr] = a[rr] * a[rr] + b[rr] * b[rr]; }
#pragma unroll
                for (int o = 1; o < 64; o <<= 1) {
#pragma unroll
                    for (int rr = 0; rr < 4; ++rr) { s1[rr] += __shfl_xor(s1[rr], o); s2[rr] += __shfl_xor(s2[rr], o); } }
#pragma unroll
                for (int rr = 0; rr < 4; ++rr) { bf16* pr = PROJ + (size_t)(r0 + rq + rr) * PS;
                    const float r1 = 1.0f / sqrtf(s1[rr] * (1.0f / 256.0f) + EPS), r2 = 1.0f / sqrtf(s2[rr] * (1.0f / 128.0f) + EPS);
                    const f32x4 q = fq[rr] * r1 * g_lq; v2u o; o.x = cvt_pk_bf16(q.x, q.y); o.y = cvt_pk_bf16(q.z, q.w);
                    *(v2u*)(pr + PC_CQ + 4 * lane) = o; *(unsigned*)(pr + PC_CKV + 2 * lane) = cvt_pk_bf16(a[rr] * r2 * g_lkv.x, b[rr] * r2 * g_lkv.y); }
            }
            {
                const float ang = pos * invf;
                float sn, cs; sincosf(ang, &sn, &cs);
                const unsigned o = cvt_pk_bf16(t1 * cs - t2 * sn, t1 * sn + t2 * cs);
                prl[PC_KR + il] = (bf16)(o & 0xffffu); prl[PC_KR + 16 + il] = (bf16)(o >> 16);
                ROPE[(size_t)rowl * 32 + il] = cs; ROPE[(size_t)rowl * 32 + 16 + il] = sn;
            }
            if (lane < 16) {
                const float v = fav + fb;
                LOGF[(size_t)rowf * 4 + (lane & 3)] = (v > 0.f) ? -log1pf(expf(-v)) : v - log1pf(expf(v));
            }
        }
    }
}

constexpr float QSCALE_C = 0.10206207261596577f * LOG2E;
DI void prep2_phase(const Frame& F, const Args& A, int layer) {
    unsigned char* ws = F.ws;
    const bf16* PROJ = (const bf16*)(ws + WS_PROJ); const bf16* QKVC = (const bf16*)(ws + WS_QKVC); const float* ROPE = (const float*)(ws + WS_ROPE);
    bf16* QC = (bf16*)(ws + WS_QC); bf16* KC = (bf16*)(ws + WS_KC);
    const int lane = F.lane, hh = lane >> 4, jj = lane & 15;
    LAS float* sq = (LAS float*)(F.lds + F.wave * 8192);
    LAS float* sk = sq + 384;
    LAS bf16* sb = (LAS bf16*)(sq + 768);
    float gq[6], gk[6];
#pragma unroll
    for (int k = 0; k < 6; ++k) { gq[k] = inp(F, 15)[layer * 96 + jj + 16 * k] * QSCALE_C; gk[k] = inp(F, 16)[layer * 96 + jj + 16 * k]; }
    const int gw = F.bx * NWAVES + F.wave, NGW = F.G * NWAVES;
    for (int r0 = gw * 16; r0 < TC; r0 += NGW * 16) {
        for (int rr = 0; rr < 16; ++rr) {
            const int row = r0 + rr;
            const bf16* qrow = QKVC + (size_t)row * 1024;
            if (lane < 48) { const v4u raw = *(const v4u*)(qrow + 8 * lane); LAS float* d = sq + 8 * lane;
                d[0] = bf_lo(raw.x); d[1] = bf_hi(raw.x); d[2] = bf_lo(raw.y); d[3] = bf_hi(raw.y); d[4] = bf_lo(raw.z); d[5] = bf_hi(raw.z); d[6] = bf_lo(raw.w); d[7] = bf_hi(raw.w); }
            { const int o = 8 * jj;
              if (o < 64) { const v4u raw = *(const v4u*)(qrow + 384 + 128 * hh + o); LAS float* d = sk + 96 * hh + o;
                d[0] = bf_lo(raw.x); d[1] = bf_hi(raw.x); d[2] = bf_lo(raw.y); d[3] = bf_hi(raw.y); d[4] = bf_lo(raw.z); d[5] = bf_hi(raw.z); d[6] = bf_lo(raw.w); d[7] = bf_hi(raw.w); } }
            if (lane < 4) { const v4u raw = *(const v4u*)(PROJ + (size_t)row * PS + PC_KR + 8 * lane);
                const float f[8] = {bf_lo(raw.x), bf_hi(raw.x), bf_lo(raw.y), bf_hi(raw.y), bf_lo(raw.z), bf_hi(raw.z), bf_lo(raw.w), bf_hi(raw.w)};
#pragma unroll
                for (int h = 0; h < 4; ++h)
#pragma unroll
                    for (int i = 0; i < 8; ++i) sk[96 * h + 64 + 8 * lane + i] = f[i]; }
            const float cs = ROPE[(size_t)row * 32 + jj], sn = ROPE[(size_t)row * 32 + 16 + jj];
            __builtin_amdgcn_wave_barrier(); asm volatile("s_waitcnt lgkmcnt(0)" ::: "memory");
            { const float t1 = sq[96 * hh + 64 + jj], t2 = sq[96 * hh + 80 + jj];
              __builtin_amdgcn_wave_barrier();
              sq[96 * hh + 64 + jj] = t1 * cs - t2 * sn; sq[96 * hh + 80 + jj] = t1 * sn + t2 * cs; }
            __builtin_amdgcn_wave_barrier(); asm volatile("s_waitcnt lgkmcnt(0)" ::: "memory");
            float qv[6], kv[6], sq2 = 0.f, sk2 = 0.f;
#pragma unroll
            for (int k = 0; k < 6; ++k) { qv[k] = sq[96 * hh + jj + 16 * k]; kv[k] = sk[96 * hh + jj + 16 * k]; sq2 += qv[k] * qv[k]; sk2 += kv[k] * kv[k]; }
            const float rq = 1.0f / sqrtf(sum16(sq2) * (1.0f / 96.0f) + EPS), rk = 1.0f / sqrtf(sum16(sk2) * (1.0f / 96.0f) + EPS);
            __builtin_amdgcn_wave_barrier();
#pragma unroll
            for (int k = 0; k < 6; ++k) { const unsigned o = cvt_pk_bf16(qv[k] * rq * gq[k], kv[k] * rk * gk[k]);
                sb[96 * hh + jj + 16 * k] = (bf16)(o & 0xffffu); sb[384 + 96 * hh + jj + 16 * k] = (bf16)(o >> 16); }
            __builtin_amdgcn_wave_barrier(); asm volatile("s_waitcnt lgkmcnt(0)" ::: "memory");
            if (lane < 48) { *(v4u*)(QC + (size_t)row * 384 + 8 * lane) = *(const LAS v4u*)(sb + 8 * lane); *(v4u*)(KC + (size_t)row * 384 + 8 * lane) = *(const LAS v4u*)(sb + 384 + 8 * lane); }
            __builtin_amdgcn_wave_barrier(); asm volatile("s_waitcnt lgkmcnt(0)" ::: "memory");
        }
    }
}

DI void route_phase(const Frame& F) {
    unsigned char* ws = F.ws;
    const int* CNT = (const int*)(ws + WS_CNT); const int* TOKE = (const int*)(ws + WS_TOKE); int* TOKPOS = (int*)(ws + WS_TOKPOS);
    int* TILEEXP = (int*)(ws + WS_TILEEXP);
    const bf16* H = (const bf16*)(ws + WS_H); bf16* HS = (bf16*)(ws + WS_HS);
    LAS int* cntL = (LAS int*)F.lds;
    LAS int* totL = cntL + 4096;
    LAS int* preL = totL + 16;
    LAS int* baseL = preL + 16;
    LAS int* wc0L = baseL + 16;
    LAS int* posL = wc0L + 16;
    constexpr int NRB = TC / 128;
    for (int idx = F.tid; idx < NRB * 16; idx += NTHREADS) cntL[idx] = CNT[idx];
    __syncthreads();
    for (int rb = F.bx; rb < NRB; rb += F.G) {
        if (F.tid < 16) { int tot = 0, pre = 0; for (int t = 0; t < NRB; ++t) { const int c = cntL[t * 16 + F.tid]; if (t < rb) pre += c; tot += c; } totL[F.tid] = tot; preL[F.tid] = pre; }
        __syncthreads();
        if (F.tid == 0) { int base = 0; for (int e = 0; e < 16; ++e) { baseL[e] = base; base += ((totL[e] + 255) >> 8) << 8; }
            if (rb == 0) { int m = 0; for (int e = 0; e < 16; ++e) { const int nt = (totL[e] + 255) >> 8; for (int j = 0; j < nt; ++j) TILEEXP[m++] = e; } TILEEXP[NMT_WORD] = m; } }
        __syncthreads();
        if (F.tid < 128) {
            const int t = rb * 128 + F.tid; const int e0 = TOKE[t * 2], e1 = TOKE[t * 2 + 1];
            int rk0 = 0, rk1 = 0;
            const unsigned long long lt = (1ull << F.lane) - 1ull;
            for (int e = 0; e < 16; ++e) {
                const unsigned long long m = __ballot(e0 == e || e1 == e);
                const int r = __popcll(m & lt);
                if (e0 == e) rk0 = r; if (e1 == e) rk1 = r;
                if (F.wave == 0 && F.lane == 0) wc0L[e] = __popcll(m);
            }
            asm volatile("s_waitcnt lgkmcnt(0)" ::: "memory");
            posL[256 + F.tid * 2] = rk0; posL[256 + F.tid * 2 + 1] = rk1;
        }
        __syncthreads();
        if (F.tid < 128) {
            const int t = rb * 128 + F.tid; const int e0 = TOKE[t * 2], e1 = TOKE[t * 2 + 1];
            const int add0 = (F.wave == 1) ? wc0L[e0] : 0, add1 = (F.wave == 1) ? wc0L[e1] : 0;
            const int p0 = baseL[e0] + preL[e0] + posL[256 + F.tid * 2] + add0, p1 = baseL[e1] + preL[e1] + posL[256 + F.tid * 2 + 1] + add1;
            TOKPOS[t * 2] = p0; TOKPOS[t * 2 + 1] = p1; posL[F.tid * 2] = p0; posL[F.tid * 2 + 1] = p1;
        }
        __syncthreads();
        for (int it = F.wave * 32; it < F.wave * 32 + 32; ++it) {
            const int tl = it >> 1; const int pos = posL[it];
            const v4u* src = (const v4u*)(H + (size_t)(rb * 128 + tl) * 1024); v4u* dst = (v4u*)(HS + (size_t)pos * 1024);
            const v4u a = src[F.lane], b = src[64 + F.lane]; dst[F.lane] = a; dst[64 + F.lane] = b;
        }
        __syncthreads();
    }
}

namespace att {
constexpr int KBYTES = 12288, VBYTES = 8192;
constexpr int NSLOT = 3, L_K = 0, L_V = NSLOT * KBYTES, L_WSF = NSLOT * (KBYTES + VBYTES), L_BIAS = L_WSF + 1024, L_REL = L_BIAS + 8192, L_SCAN = L_REL + 1056, L_DONE = L_SCAN + 64, L_OST = L_DONE + 64, L_END = L_OST + 8 * 4096;
static_assert(L_END <= RING_BYTES, "attention LDS");
DI int crow(int r, int hi) { return (r & 3) + 8 * (r >> 2) + 4 * hi; }
#define MFMA32(a, b, c) __builtin_amdgcn_mfma_f32_32x32x16_bf16((a), (b), (c), 0, 0, 0)
typedef short v4i16_t __attribute__((ext_vector_type(4)));
DI s16x4 vtr(const LAS unsigned char* p) { return __builtin_bit_cast(s16x4, __builtin_amdgcn_ds_read_tr16_b64_v4i16((LAS v4i16_t*)p)); }
DI float max3f(float a, float b, float c) { return __builtin_fmaxf(__builtin_fmaxf(a, b), c); }
DI float swap_max(float m) { auto rr = __builtin_amdgcn_permlane32_swap(__float_as_uint(m), __float_as_uint(m), false, false); return fmaxf(__uint_as_float(rr[0]), __uint_as_float(rr[1])); }
DI float swap_sum(float m) { auto rr = __builtin_amdgcn_permlane32_swap(__float_as_uint(m), __float_as_uint(m), false, false); return __uint_as_float(rr[0]) + __uint_as_float(rr[1]); }

struct Tens { const bf16* Q; const bf16* K; const bf16* V; int pq, pk, pv; bf16* O; float qscale; };

template <int MIX>
DI void attn_unit(const Frame& F, const Tens& T, int b, int h, int qb, const float* logf, const float* relb) {
    constexpr int DQK = (MIX == 2) ? 96 : 64, NKS = DQK / 16;
    LAS unsigned char* lds = F.lds;
    const int tid = F.tid, lane = F.lane, wid = F.wave, r32 = lane & 31, hi = lane >> 5;
    const int rowbase = b * S, q0 = qb * 256, q0w = q0 + 32 * wid, cw = q0w >> 6;
    LAS float* wsf = (LAS float*)(lds + L_WSF) + wid * 32;
    LAS float* biasL = (LAS float*)(lds + L_BIAS);
    LAS float* relL = (LAS float*)(lds + L_REL);
    __syncthreads();
    const int t_hi = 4 * qb + 3;
    const int t_lo = (MIX == 3) ? ((4 * qb - 8) > 0 ? (4 * qb - 8) : 0) : 0;
    const int ntile = t_hi - t_lo + 1;
    const char* Kb = (const char*)(T.K + (size_t)rowbase * T.pk); const char* Vb = (const char*)(T.V + (size_t)rowbase * T.pv);
    const unsigned koff0 = (unsigned)(((tid & 63) * T.pk + 8 * (tid >> 6)) * 2);
    const unsigned voff = (unsigned)(((16 * (wid & 3) + (lane >> 2)) * T.pv + (wid >> 2) * 32 + (lane & 3) * 8) * 2);
    const bool k2 = (DQK == 96) && (wid < 4);
#define ATT_ISSUE(t, slot) do { const char* kt = Kb + (size_t)(t) * 128 * T.pk; const char* vt = Vb + (size_t)(t) * 128 * T.pv; \
        __builtin_amdgcn_global_load_lds((const unsigned*)(kt + koff0), (LAS unsigned*)(lds + L_K + (slot) * KBYTES + wid * 1024), 16, 0, 0); \
        if (k2) __builtin_amdgcn_global_load_lds((const unsigned*)(kt + koff0 + 128), (LAS unsigned*)(lds + L_K + (slot) * KBYTES + 8192 + wid * 1024), 16, 0, 0); \
        __builtin_amdgcn_global_load_lds((const unsigned*)(vt + voff), (LAS unsigned*)(lds + L_V + (slot) * VBYTES + wid * 1024), 16, 0, 0); } while (0)
#define ATT_WAITBAR(n) asm volatile("s_waitcnt vmcnt(" #n ") lgkmcnt(0)\n\ts_barrier" ::: "memory")
#define ATT_WAIT_NEWEST() do { if (k2) ATT_WAITBAR(3); else ATT_WAITBAR(2); } while (0)
#define ATT_TILE(it) ((MIX == 1) ? (t_hi - (it)) : (t_lo + (it)))
    ATT_ISSUE(ATT_TILE(0), 0);
    if (ntile > 1) ATT_ISSUE(ATT_TILE(1), 1);
    if (MIX == 0) {
        LAS float* scanL = (LAS float*)(lds + L_SCAN);
        float lf[4]; float run = 0.f;
#pragma unroll
        for (int i = 0; i < 4; ++i) { run += logf[(size_t)(rowbase + 4 * tid + i) * 4 + h]; lf[i] = run; }
        float inc = run;
#pragma unroll
        for (int o = 1; o < 64; o <<= 1) { const float t = __shfl_up(inc, o); if (lane >= o) inc += t; }
        if (lane == 63) scanL[wid] = inc;
        asm volatile("s_waitcnt lgkmcnt(0)\n\ts_barrier" ::: "memory");
        float off = inc - run;
        for (int w = 0; w < wid; ++w) off += scanL[w];
#pragma unroll
        for (int i = 0; i < 4; ++i) biasL[4 * tid + i] = -LOG2E * (off + lf[i]);
    }
    if (MIX == 3) { const float far = relb[256]; for (int i = tid; i < 257; i += NTHREADS) relL[i] = (relb[i] - far) * LOG2E; }
    bf16x8 qr[NKS];
    {
        const char* qb_ = (const char*)(T.Q + (size_t)(rowbase + q0w) * T.pq); const unsigned qoff = (unsigned)((r32 * T.pq + 8 * hi) * 2);
#pragma unroll
        for (int d0 = 0; d0 < NKS; ++d0) { const v4u raw = *(const v4u*)(qb_ + qoff + 32 * d0); v4u s;
            s.x = cvt_pk_bf16(bf_lo(raw.x) * T.qscale, bf_hi(raw.x) * T.qscale); s.y = cvt_pk_bf16(bf_lo(raw.y) * T.qscale, bf_hi(raw.y) * T.qscale);
            s.z = cvt_pk_bf16(bf_lo(raw.z) * T.qscale, bf_hi(raw.z) * T.qscale); s.w = cvt_pk_bf16(bf_lo(raw.w) * T.qscale, bf_hi(raw.w) * T.qscale);
            qr[d0] = __builtin_bit_cast(bf16x8, s); }
    }
    f32x16 o0, o1;
#pragma unroll
    for (int i = 0; i < 16; ++i) { o0[i] = 0.f; o1[i] = 0.f; }
    float mrun = -1.0e30f, lrun = 0.f, arun = 0.f;
    bool bdone = false;
    LAS int* doneL = (LAS int*)(lds + L_DONE);
    ATT_WAITBAR(0);
    int slot = 0;
    for (int it = 0; it < ntile; ++it) {
        const int t = ATT_TILE(it);
        const bool more = (it + 2 < ntile);
        if (more) { const int s2 = (slot == 0) ? 2 : slot - 1; ATT_ISSUE(ATT_TILE(it + 2), s2); }
        const bool part = (MIX == 3) ? (t <= cw && t >= cw - 8) : ((MIX == 1) ? (t <= cw && !bdone) : (t <= cw));
        if (part) {
            const LAS unsigned char* kb = lds + L_K + slot * KBYTES + hi * 1024 + r32 * 16;
            f32x16 p0, p1;
            if (MIX == 0) {
                const LAS f32x4* bp = (const LAS f32x4*)(biasL + 64 * t + 4 * hi);
#pragma unroll
                for (int g = 0; g < 4; ++g) { const f32x4 b0 = bp[2 * g], b1 = bp[8 + 2 * g];
                    p0[4 * g] = b0.x; p0[4 * g + 1] = b0.y; p0[4 * g + 2] = b0.z; p0[4 * g + 3] = b0.w; p1[4 * g] = b1.x; p1[4 * g + 1] = b1.y; p1[4 * g + 2] = b1.z; p1[4 * g + 3] = b1.w; }
            } else {
#pragma unroll
                for (int i = 0; i < 16; ++i) { p0[i] = 0.f; p1[i] = 0.f; }
            }
#pragma unroll
            for (int d0 = 0; d0 < NKS; ++d0) { const bf16x8 a0 = *(const LAS bf16x8*)(kb + d0 * 2048), a1 = *(const LAS bf16x8*)(kb + d0 * 2048 + 512);
                p0 = MFMA32(a0, qr[d0], p0); p1 = MFMA32(a1, qr[d0], p1); }
            const int qabs = q0w + r32, kv0 = 64 * t + 4 * hi;
            if (MIX == 1) {
                const bool diag = (t == cw);
                float lb0[16], lb1[16], gsum[8];
#pragma unroll
                for (int g = 0; g < 8; ++g) gsum[g] = 0.f;
#pragma unroll
                for (int i = 0; i < 16; ++i) {
                    const int kvA = kv0 + (i & 3) + 8 * (i >> 2);
                    { const float z = p0[i]; const float sp = fmaxf(z, 0.f) + fast_log2(1.0f + fast_exp2(-fabsf(z))); const bool valid = !diag || (kvA < qabs);
                      lb0[i] = valid ? z - sp : -1.0e30f; const float lk = valid ? -sp : 0.f; p0[i] = lk; gsum[i >> 2] += lk; }
                    { const float z = p1[i]; const float sp = fmaxf(z, 0.f) + fast_log2(1.0f + fast_exp2(-fabsf(z))); const bool valid = !diag || (kvA + 32 < qabs);
                      lb1[i] = valid ? z - sp : -1.0e30f; const float lk = valid ? -sp : 0.f; p1[i] = lk; gsum[4 + (i >> 2)] += lk; }
                }
                float Lg[8], Hg[8];
#pragma unroll
                for (int g = 0; g < 8; ++g) { auto rr = __builtin_amdgcn_permlane32_swap(__float_as_uint(gsum[g]), __float_as_uint(gsum[g]), false, false); Lg[g] = __uint_as_float(rr[0]); Hg[g] = __uint_as_float(rr[1]); }
                float suf = arun;
#pragma unroll
                for (int g = 7; g >= 0; --g) {
                    const float ag = suf + (hi == 0 ? Hg[g] : 0.f);
                    float within = 0.f;
#pragma unroll
                    for (int j = 3; j >= 0; --j) {
                        const int i = (g & 3) * 4 + j;
                        if (g < 4) { const float lk = p0[i]; p0[i] = fast_exp2(lb0[i] + ag + within); within += lk; }
                        else { const float lk = p1[i]; p1[i] = fast_exp2(lb1[i] + ag + within); within += lk; }
                    }
                    suf += Lg[g] + Hg[g];
                }
                arun = suf;
                if (__all(arun < -150.0f)) bdone = true;
            } else {
                if (MIX == 0) {
                    if (t == cw) {
#pragma unroll
                        for (int i = 0; i < 16; ++i) { const int kvA = kv0 + (i & 3) + 8 * (i >> 2); if (kvA > qabs) p0[i] = -1.0e30f; if (kvA + 32 > qabs) p1[i] = -1.0e30f; }
                    }
                }
                if (MIX == 3 && (cw - t) < 3) {
#pragma unroll
                    for (int i = 0; i < 16; ++i) { const int kvA = kv0 + (i & 3) + 8 * (i >> 2); int d0i = qabs - kvA; int d1i = d0i - 32;
                        d0i = d0i < -128 ? -128 : (d0i > 128 ? 128 : d0i); d1i = d1i < -128 ? -128 : (d1i > 128 ? 128 : d1i);
                        p0[i] += relL[d0i + 128]; p1[i] += relL[d1i + 128]; }
                }
                float rm = max3f(p0[0], p1[0], p0[1]), rm2 = max3f(p1[1], p0[2], p1[2]);
#pragma unroll
                for (int i = 3; i < 15; i += 2) { rm = max3f(rm, p0[i], p1[i]); rm2 = max3f(rm2, p0[i + 1], p1[i + 1]); }
                rm = max3f(rm, rm2, fmaxf(p0[15], p1[15]));
                rm = swap_max(rm);
                const float mnew = fmaxf(mrun, rm);
                const float f = fast_exp2(mrun - mnew);
                mrun = mnew; lrun *= f;
                float sacc = 0.f;
#pragma unroll
                for (int i = 0; i < 16; ++i) { p0[i] = fast_exp2(p0[i] - mnew); p1[i] = fast_exp2(p1[i] - mnew); sacc += p0[i] + p1[i]; }
                lrun += sacc;
                if (__any(f != 1.0f)) {
                    if (hi == 0) wsf[r32] = f;
                    __builtin_amdgcn_wave_barrier(); asm volatile("s_waitcnt lgkmcnt(0)" ::: "memory");
#pragma unroll
                    for (int i = 0; i < 16; ++i) { const float ff = wsf[crow(i, hi)]; o0[i] *= ff; o1[i] *= ff; }
                    __builtin_amdgcn_wave_barrier();
                }
            }
            v4u pw[4];
#pragma unroll
            for (int s = 0; s < 2; ++s) { pw[s].x = cvt_pk_bf16(p0[8 * s], p0[8 * s + 1]); pw[s].y = cvt_pk_bf16(p0[8 * s + 2], p0[8 * s + 3]); pw[s].z = cvt_pk_bf16(p0[8 * s + 4], p0[8 * s + 5]); pw[s].w = cvt_pk_bf16(p0[8 * s + 6], p0[8 * s + 7]);
                pw[2 + s].x = cvt_pk_bf16(p1[8 * s], p1[8 * s + 1]); pw[2 + s].y = cvt_pk_bf16(p1[8 * s + 2], p1[8 * s + 3]); pw[2 + s].z = cvt_pk_bf16(p1[8 * s + 4], p1[8 * s + 5]); pw[2 + s].w = cvt_pk_bf16(p1[8 * s + 6], p1[8 * s + 7]); }
            const unsigned vp = (unsigned)(size_t)(lds + L_V + slot * VBYTES + ((lane >> 4) & 1) * 32 + (lane & 3) * 8 + (4 * hi + ((lane & 15) >> 2)) * 64);
#define ATT_TR(dst, off) asm volatile("ds_read_b64_tr_b16 %0, %1 offset:%c2" : "=&v"(dst) : "v"(vp), "i"(off) : "memory")
            {
                s16x4 lo[4], hh[4];
#pragma unroll
                for (int ks = 0; ks < 4; ++ks) { ATT_TR(lo[ks], ks * 1024); ATT_TR(hh[ks], ks * 1024 + 512); }
                asm volatile("s_waitcnt lgkmcnt(0)" ::: "memory"); __builtin_amdgcn_sched_barrier(0);
#pragma unroll
                for (int ks = 0; ks < 4; ++ks) { const bf16x8 vf = {lo[ks][0], lo[ks][1], lo[ks][2], lo[ks][3], hh[ks][0], hh[ks][1], hh[ks][2], hh[ks][3]}; o0 = MFMA32(__builtin_bit_cast(bf16x8, pw[ks]), vf, o0); }
#pragma unroll
                for (int ks = 0; ks < 4; ++ks) { ATT_TR(lo[ks], 4096 + ks * 1024); ATT_TR(hh[ks], 4096 + ks * 1024 + 512); }
                asm volatile("s_waitcnt lgkmcnt(0)" ::: "memory"); __builtin_amdgcn_sched_barrier(0);
#pragma unroll
                for (int ks = 0; ks < 4; ++ks) { const bf16x8 vf = {lo[ks][0], lo[ks][1], lo[ks][2], lo[ks][3], hh[ks][0], hh[ks][1], hh[ks][2], hh[ks][3]}; o1 = MFMA32(__builtin_bit_cast(bf16x8, pw[ks]), vf, o1); }
            }
#undef ATT_TR
        }
        if (MIX == 1) { if (lane == 0) doneL[(it & 1) * 8 + wid] = bdone ? 1 : 0; }
        if (more) ATT_WAIT_NEWEST(); else ATT_WAITBAR(0);
        slot = (slot == 2) ? 0 : slot + 1;
        if (MIX == 1) {
            const int fl = (lane < 8) ? doneL[(it & 1) * 8 + lane] : 1;
            if (__all(fl != 0)) { ATT_WAITBAR(0); break; }
        }
    }
    {
        if (MIX != 1) {
            const float lt = swap_sum(lrun);
            if (hi == 0) wsf[r32] = fast_rcp(lt);
            __builtin_amdgcn_wave_barrier(); asm volatile("s_waitcnt lgkmcnt(0)" ::: "memory");
#pragma unroll
            for (int i = 0; i < 16; ++i) { const float ff = wsf[crow(i, hi)]; o0[i] *= ff; o1[i] *= ff; }
        }
        LAS bf16* stg = (LAS bf16*)(lds + L_OST) + wid * 2048;
#pragma unroll
        for (int i = 0; i < 16; ++i) { const int orow = crow(i, hi); const unsigned pk = cvt_pk_bf16(o0[i], o1[i]); stg[orow * 64 + r32] = (bf16)(pk & 0xffffu); stg[orow * 64 + 32 + r32] = (bf16)(pk >> 16); }
        __builtin_amdgcn_wave_barrier(); asm volatile("s_waitcnt lgkmcnt(0)" ::: "memory");
        char* Ow = (char*)(T.O + (size_t)(rowbase + q0w) * 1024);
#pragma unroll
        for (int i = 0; i < 4; ++i) { const int row = i * 8 + (lane >> 3), ch = lane & 7; const v4u v = *(const LAS v4u*)(stg + row * 64 + ch * 8); *(v4u*)(Ow + (unsigned)((row * 1024 + ch * 8) * 2)) = v; }
    }
#undef ATT_ISSUE
#undef ATT_WAITBAR
#undef ATT_WAIT_NEWEST
#undef ATT_TILE
}

DI void attn_phase(const Frame& F, const Args& A, int layer) {
    unsigned char* ws = F.ws;
    const bf16* PROJ = (const bf16*)(ws + WS_PROJ); bf16* O = (bf16*)(ws + WS_O);
    const float* logf = (const float*)(ws + WS_LOGF);
    const float sc8 = 0.125f * LOG2E;
    for (int p = F.bx; p < NBC * 16; p += F.G) {
        const int bh = p >> 2, b = bh >> 2, h = bh & 3, x = p & 3;
        { Tens T{PROJ + PA_Q + 64 * h, PROJ + PA_K + 64 * h, PROJ + PA_V + 64 * h, PS, PS, PS, O + 0 + 64 * h, sc8};
          for (int j = 0; j < 2; ++j) attn_unit<0>(F, T, b, h, j ? 7 - x : x, logf, nullptr); }
        { Tens T{PROJ + PB_Q + 64 * h, PROJ + PB_K + 64 * h, PROJ + PB_V + 64 * h, PS, PS, PS, O + 256 + 64 * h, sc8};
          for (int j = 0; j < 2; ++j) attn_unit<1>(F, T, b, h, j ? 7 - x : x, nullptr, nullptr); }
        { Tens T{(const bf16*)(ws + WS_QC) + 96 * h, (const bf16*)(ws + WS_KC) + 96 * h, (const bf16*)(ws + WS_QKVC) + 384 + 128 * h + 64, 384, 384, 1024, O + 512 + 64 * h, 1.0f};
          for (int j = 0; j < 2; ++j) attn_unit<2>(F, T, b, h, j ? 7 - x : x, nullptr, nullptr); }
        { Tens T{PROJ + PD_Q + 64 * h, PROJ + PD_K + 64 * h, PROJ + PD_V + 64 * h, PS, PS, PS, O + 768 + 64 * h, sc8};
          const float* relb = inp(F, 19) + ((size_t)layer * 4 + h) * 257;
          for (int j = 0; j < 2; ++j) attn_unit<3>(F, T, b, h, j ? 7 - x : x, nullptr, relb); }
    }
    __syncthreads();
}
}
#ifndef MK_MULTI
#define MK_MULTI 0
#endif

using pg8::Unit; using pg8::Acc;
DI void pack8_store(bf16* p, const f32x4 v0, const f32x4 v1) { v4u w; w.x = cvt_pk_bf16(v0[0], v0[1]); w.y = cvt_pk_bf16(v0[2], v0[3]); w.z = cvt_pk_bf16(v1[0], v1[1]); w.w = cvt_pk_bf16(v1[2], v1[3]); *(v4u*)p = w; }
DI f32x4 sig4(const f32x4 v) { return (f32x4){sigmoid_f(v[0]), sigmoid_f(v[1]), sigmoid_f(v[2]), sigmoid_f(v[3])}; }
DI void unpack8(const v4u raw, f32x4& a, f32x4& b) { a = (f32x4){bf_lo(raw.x), bf_hi(raw.x), bf_lo(raw.y), bf_hi(raw.y)}; b = (f32x4){bf_lo(raw.z), bf_hi(raw.z), bf_lo(raw.w), bf_hi(raw.w)}; }

struct EpiStore {
    static constexpr bool PERM = true, CHAIN = false;
    bf16* O; int ldc; int sig_pn; float scale;
    DI void operator()(Acc& acc, const Unit& u, bool, const Unit&, int wr, int wc, int fr, int fq) const {
        const int row0 = u.pm * 256 + wr * 64 + fr, col0 = u.pn * 256 + wc * 32 + 8 * fq;
        const bool sg = u.pn >= sig_pn;
#pragma unroll
        for (int ai = 0; ai < 2; ++ai)
#pragma unroll
            for (int m = 0; m < 4; ++m) { bf16* rowp = O + (size_t)(row0 + ai * 128 + m * 16) * ldc + col0;
#pragma unroll
                for (int bj = 0; bj < 2; ++bj) { f32x4 v0 = acc[ai][bj][m][0], v1 = acc[ai][bj][m][1]; if (sg) { v0 = sig4(v0 * scale); v1 = sig4(v1 * scale); } pack8_store(rowp + bj * 128, v0, v1); } }
    }
};
struct EpiSwiGLU {
    static constexpr bool PERM = true, CHAIN = false;
    bf16* O;
    DI void operator()(Acc& acc, const Unit& u, bool, const Unit&, int wr, int wc, int fr, int fq) const {
        const int row0 = u.pm * 256 + wr * 64 + fr, col0 = u.pn * 128 + wc * 32 + 8 * fq;
#pragma unroll
        for (int ai = 0; ai < 2; ++ai)
#pragma unroll
            for (int m = 0; m < 4; ++m) { bf16* rowp = O + (size_t)(row0 + ai * 128 + m * 16) * 256 + col0;
                const f32x4 g0 = acc[ai][0][m][0], g1 = acc[ai][0][m][1];
                pack8_store(rowp, g0 * sig4(g0) * acc[ai][1][m][0], g1 * sig4(g1) * acc[ai][1][m][1]); }
    }
};
struct EpiGateChain {
    static constexpr bool PERM = true, CHAIN = true;
    const unsigned char* G;
    bf16* O;
    DI void operator()(Acc& acc, const Unit& u, bool, const Unit&, int wr, int wc, int fr, int fq) const {
        const int row0 = u.pm * 256 + wr * 64 + fr, col0 = u.pn * 256 + wc * 32 + 8 * fq, b = u.aux;
        const int wid = wr * 4 + wc, lane = fq * 16 + fr;
        const unsigned char* gt = G + ((size_t)((b * (TC / 256) + u.pm) * 4 + u.pn) * 65536) + (size_t)(wid * 64 + lane) * 8;
#pragma unroll
        for (int ai = 0; ai < 2; ++ai) {
            v2u gc[4][2];
#pragma unroll
            for (int m = 0; m < 4; ++m)
#pragma unroll
                for (int bj = 0; bj < 2; ++bj) gc[m][bj] = *(const v2u*)(gt + (size_t)(((ai * 4 + m) * 2 + bj) * 512) * 8);
#pragma unroll
            for (int m = 0; m < 4; ++m) {
                const size_t r = (size_t)(row0 + ai * 128 + m * 16);
#pragma unroll
                for (int bj = 0; bj < 2; ++bj) {
                    const f32x4 c0 = unpk4_fp8(gc[m][bj].x), c1 = unpk4_fp8(gc[m][bj].y);
                    if (b == 3) { pack8_store(O + r * 1024 + col0 + bj * 128, acc[ai][bj][m][0] * c0, acc[ai][bj][m][1] * c1);
                        acc[ai][bj][m][0] = (f32x4){0.f, 0.f, 0.f, 0.f}; acc[ai][bj][m][1] = (f32x4){0.f, 0.f, 0.f, 0.f}; }
                    else { acc[ai][bj][m][0] = acc[ai][bj][m][0] * c0; acc[ai][bj][m][1] = acc[ai][bj][m][1] * c1; }
                }
            }
            asm volatile("" ::: "memory");
        }
    }
};
struct EpiResGate {
    static constexpr bool PERM = true, CHAIN = false;
    const float* xin32; const bf16* xin16; bf16* xout; const float* modg;
    DI void operator()(Acc& acc, const Unit& u, bool, const Unit&, int wr, int wc, int fr, int fq) const {
        const int col0 = u.pn * 256 + wc * 32 + 8 * fq;
        const float* gv = modg + (size_t)((u.pm * 256) / S) * 6144 + col0;
        f32x4 g[2][2];
#pragma unroll
        for (int bj = 0; bj < 2; ++bj)
#pragma unroll
            for (int n = 0; n < 2; ++n) g[bj][n] = *(const f32x4*)(gv + bj * 128 + n * 4);
        const size_t off0 = (size_t)(u.pm * 256 + wr * 64 + fr) * D + col0;
        if (xin32) {
#pragma unroll
            for (int ai = 0; ai < 2; ++ai)
#pragma unroll
                for (int mp = 0; mp < 4; mp += 2) {
                    f32x4 x[2][2][2];
#pragma unroll
                    for (int mm = 0; mm < 2; ++mm)
#pragma unroll
                        for (int bj = 0; bj < 2; ++bj) { const float* p = xin32 + off0 + (size_t)(ai * 128 + (mp + mm) * 16) * D + bj * 128; x[mm][bj][0] = *(const f32x4*)p; x[mm][bj][1] = *(const f32x4*)(p + 4); }
#pragma unroll
                    for (int mm = 0; mm < 2; ++mm)
#pragma unroll
                        for (int bj = 0; bj < 2; ++bj) pack8_store(xout + off0 + (size_t)(ai * 128 + (mp + mm) * 16) * D + bj * 128, x[mm][bj][0] + g[bj][0] * acc[ai][bj][mp + mm][0], x[mm][bj][1] + g[bj][1] * acc[ai][bj][mp + mm][1]);
                    asm volatile("" ::: "memory"); }
        } else {
#pragma unroll
            for (int ai = 0; ai < 2; ++ai) {
                v4u xr[4][2];
#pragma unroll
                for (int m = 0; m < 4; ++m)
#pragma unroll
                    for (int bj = 0; bj < 2; ++bj) xr[m][bj] = *(const v4u*)(xin16 + off0 + (size_t)(ai * 128 + m * 16) * D + bj * 128);
#pragma unroll
                for (int m = 0; m < 4; ++m)
#pragma unroll
                    for (int bj = 0; bj < 2; ++bj) { f32x4 x0, x1; unpack8(xr[m][bj], x0, x1); pack8_store(xout + off0 + (size_t)(ai * 128 + m * 16) * D + bj * 128, x0 + g[bj][0] * acc[ai][bj][m][0], x1 + g[bj][1] * acc[ai][bj][m][1]); }
                asm volatile("" ::: "memory"); }
        }
    }
};
struct EpiMoeOut {
    static constexpr bool PERM = true, CHAIN = false;
    const bf16* xin; bf16* xout16; float* xout32; const float* modg; const bf16* Y; const int* tokpos; const float* tokw; const LAS int* tb;
    DI void operator()(Acc& acc, const Unit& u, bool, const Unit&, int wr, int wc, int fr, int fq) const {
        const int col0 = u.pn * 256 + wc * 32 + 8 * fq;
        const float* gv = modg + (size_t)((u.pm * 256) / S) * 6144 + col0;
        f32x4 g[2][2];
#pragma unroll
        for (int bj = 0; bj < 2; ++bj)
#pragma unroll
            for (int n = 0; n < 2; ++n) g[bj][n] = *(const f32x4*)(gv + bj * 128 + n * 4);
#pragma unroll
        for (int ai = 0; ai < 2; ++ai)
#pragma unroll
            for (int mp = 0; mp < 4; mp += 2) {
                v4u xr[2][2], ya[2][2], yb[2][2]; float w0[2], w1[2]; size_t off[2];
#pragma unroll
                for (int mm = 0; mm < 2; ++mm) { const int row = u.pm * 256 + ai * 128 + wr * 64 + (mp + mm) * 16 + fr; off[mm] = (size_t)row * D + col0;
                    const int s0 = tokpos[row * 2], s1 = tokpos[row * 2 + 1]; w0[mm] = tokw[row * 2]; w1[mm] = tokw[row * 2 + 1];
                    const int p0 = tb[s0 >> 20] * 256 + (s0 & 0xfffff), p1 = tb[s1 >> 20] * 256 + (s1 & 0xfffff);
                    const bf16* y0 = Y + (size_t)p0 * 1024 + col0; const bf16* y1 = Y + (size_t)p1 * 1024 + col0;
#pragma unroll
                    for (int bj = 0; bj < 2; ++bj) { xr[mm][bj] = *(const v4u*)(xin + off[mm] + bj * 128); ya[mm][bj] = *(const v4u*)(y0 + bj * 128); yb[mm][bj] = *(const v4u*)(y1 + bj * 128); } }
#pragma unroll
                for (int mm = 0; mm < 2; ++mm)
#pragma unroll
                    for (int bj = 0; bj < 2; ++bj) { f32x4 x0, x1, a0, a1, b0, b1; unpack8(xr[mm][bj], x0, x1); unpack8(ya[mm][bj], a0, a1); unpack8(yb[mm][bj], b0, b1);
                        const f32x4 r0 = x0 + g[bj][0] * (acc[ai][bj][mp + mm][0] + a0 * w0[mm] + b0 * w1[mm]), r1 = x1 + g[bj][1] * (acc[ai][bj][mp + mm][1] + a1 * w0[mm] + b1 * w1[mm]);
                        if (xout32) { *(f32x4*)(xout32 + off[mm] + bj * 128) = r0; *(f32x4*)(xout32 + off[mm] + bj * 128 + 4) = r1; } else pack8_store(xout16 + off[mm] + bj * 128, r0, r1); }
                asm volatile("" ::: "memory"); }
    }
};

struct SchedDense {
    int nM, nN, nwg, G, c; const char* A; const char* B; size_t atile, btile;
    DI void init(int nM_, int nN_, int G_, int c_, const void* A_, size_t atile_, const void* B_, size_t btile_) { nM = nM_; nN = nN_; nwg = nM * nN; G = G_; c = c_; A = (const char*)A_; B = (const char*)B_; atile = atile_; btile = btile_; }
    DI bool next(int i, Unit& u) const {
        const long L = (long)i * G + c; if (L >= nwg) return false;
        int wgid = (int)L; { const int q = nwg / 8, r = nwg % 8, xcd = wgid % 8, off = wgid / 8; wgid = (xcd < r ? xcd * (q + 1) : r * (q + 1) + (xcd - r) * q) + off; }
        const int nig = 8 * nN, gid = wgid / nig, fm = gid * 8, gsz = (nM - fm) < 8 ? (nM - fm) : 8;
        u.pm = fm + ((wgid % nig) % gsz); u.pn = (wgid % nig) / gsz; u.aux = 0;
        u.pa = A + (size_t)u.pm * atile; u.pb = B + (size_t)u.pn * btile; return true;
    }
};
struct SchedBranch {
    int ntile, G, c; const char* O; const char* W;
    DI bool next(int i, Unit& u) const {
        const long ti = (long)(i >> 2) * G + c; if (ti >= ntile) return false;
        const int b = i & 3; u.pm = (int)(ti >> 2); u.pn = (int)(ti & 3); u.aux = b;
        u.pa = O + (size_t)u.pm * (256 * 1024 * 2) + b * 512; u.pb = W + (size_t)b * (1024 * 256 * 2) + (size_t)u.pn * (256 * 256 * 2); return true;
    }
};
DI void moe_tables(const Frame& F, int set) {
    LAS int* ne = (LAS int*)(F.lds + MOET_OFF); LAS int* tb = ne + 16;
    __syncthreads();
    if (F.tid < 16) ne[F.tid] = (int)__hip_atomic_load((unsigned*)(F.ws + WS_CTL) + CW_GCNT + 64 * set + F.tid, __ATOMIC_RELAXED, __HIP_MEMORY_SCOPE_AGENT);
    __syncthreads();
    if (F.tid == 0) { int t = 0; for (int e = 0; e < 16; ++e) { tb[e] = t; t += (ne[e] + 255) >> 8; } tb[16] = t; }
    __syncthreads();
}
DI int moe_tile_expert(const LAS int* tb, int m) { int e = 0;
#pragma unroll
    for (int k = 1; k < 16; ++k) e += (m >= tb[k]) ? 1 : 0;
    return e; }
struct SchedMoeUp {
    int G, c; const char* H; const char* W; const LAS int* tb;
    static constexpr int NSH = (TC / 256) * 2;
    DI bool next(int i, Unit& u) const {
        const long L = (long)i * G + c;
        if (L < NSH) { u.pm = (int)(L >> 1); u.pn = (int)(L & 1); u.aux = 16; u.pa = H; u.pb = W + (size_t)16 * (512 * 1024 * 2) + (size_t)u.pn * (256 * 1024 * 2); return true; }
        const int r = (int)(L - NSH), m = r >> 1;
        if (m >= tb[16]) return false;
        const int e = moe_tile_expert(tb, m); u.pm = TC / 256 + m; u.pn = r & 1; u.aux = e;
        u.pa = H; u.pb = W + (size_t)e * (512 * 1024 * 2) + (size_t)u.pn * (256 * 1024 * 2); return true;
    }
};
DI void moe_fill_rows(const Frame& F, const SchedMoeUp& S) {
    LAS int* rows = (LAS int*)(F.lds + ROWS_OFF); const LAS int* ne = (const LAS int*)(F.lds + MOET_OFF); const LAS int* tb = ne + 16;
    const int* LIST = (const int*)(F.ws + WS_LIST);
    for (int i = 0; i < 12; ++i) {
        const long L = (long)i * S.G + S.c;
        if (L < SchedMoeUp::NSH) { if (F.tid < 256) rows[i * 256 + F.tid] = (int)(L >> 1) * 256 + F.tid; continue; }
        const int m = (int)(L - SchedMoeUp::NSH) >> 1; if (m >= tb[16]) break;
        const int e = moe_tile_expert(tb, m), idx = (m - tb[e]) * 256 + F.tid;
        if (F.tid < 256) rows[i * 256 + F.tid] = (idx < ne[e]) ? LIST[e * TC + idx] : 0;
    }
    __syncthreads();
}
struct SchedMoeDn {
    int G, c; const char* HID; const char* W; const LAS int* tb;
    DI bool next(int i, Unit& u) const {
        const long L = (long)i * G + c; const int m = (int)(L >> 2);
        if (m >= tb[16]) return false;
        const int e = moe_tile_expert(tb, m); u.pm = m; u.pn = (int)(L & 3); u.aux = e;
        u.pa = HID + (size_t)(TC + m * 256) * 512; u.pb = W + (size_t)e * (1024 * 256 * 2) + (size_t)u.pn * (256 * 256 * 2); return true;
    }
};

#ifndef ONLY_PH
#define ONLY_PH -1
#endif
#define ONLY_PH_P0 (ONLY_PH < 0 || ONLY_PH == 0)
enum { PH_NORM1 = 1, PH_INPROJ, PH_PREP1, PH_MLAG, PH_PREP2, PH_ATTN, PH_BRANCH, PH_OUT, PH_NORM2, PH_ROUTE, PH_MOEUP, PH_MOEDN, PH_MOEOUT, PH_END };

DI bool launder(Frame& F, unsigned char*& ws, unsigned char* wsa) {
    int w_ = F.wave; asm volatile("" : "+s"(w_));
    int l_ = (int)__builtin_amdgcn_mbcnt_hi(~0u, __builtin_amdgcn_mbcnt_lo(~0u, 0u)); asm volatile("" : "+v"(l_));
    F.lane = l_; F.tid = w_ * 64 + l_;
    asm volatile("" : "+s"(wsa)); ws = wsa; F.ws = wsa; return true; }


#ifndef PROBE_DOUBLE
#define PROBE_DOUBLE 0
#endif
struct Ctx { const float* xin; float* xout; const float* modl; int chunk, layer; };
#define SITE(name) DI void name(Frame& F, const Args& args, unsigned char* ws, const Ctx& C)
SITE(site_norm1) { norm_phase<false>(F, args, C.xin, (const bf16*)(ws + WS_XB), C.chunk, C.layer); }
SITE(site_inproj) {
    {
        SchedDense Sd; Sd.init(TC / 256, PG / 256, F.G, F.bx, ws + WS_H, (size_t)256 * 1024 * 2, ws + WS_WIN + (size_t)C.layer * NP * 1024 * 2, (size_t)256 * 1024 * 2);
        EpiStore E{(bf16*)(ws + WS_PROJ), PS, 1 << 30, 1.0f};
        pg8::gemm_phase(F.lds, F.tid, 1024, 1024, 1024, Sd, E); }
    g8::gate_gemm_fp8(F.lds, F.tid, F.G, F.bx, ws + WS_H8, ws + WS_WIN + ((size_t)C.layer * NP + PG) * 1024 * 2, (unsigned char*)(ws + WS_GT), 1.0f / WG8_SCALE, TC / 256, ((TC / 256) * (PG / 256)) % F.G);
}
SITE(site_prep1) { prep1_phase(F, args, C.chunk, C.layer); }
SITE(site_mlag) {
    SchedDense Sd; Sd.init(TC / 256, 4, F.G, F.bx, ws + WS_PROJ + PC_CQ * 2, (size_t)256 * PS * 2, ws + WS_WMLA + (size_t)C.layer * 1024 * 384 * 2, (size_t)256 * 384 * 2);
    EpiStore E{(bf16*)(ws + WS_QKVC), 1024, 1 << 30, 1.0f};
    pg8::gemm_phase(F.lds, F.tid, PS, 384, 384, Sd, E); }
SITE(site_prep2) { prep2_phase(F, args, C.layer); }
SITE(site_attn) { att::attn_phase(F, args, C.layer); }
SITE(site_branch) {
    SchedBranch Sb{(TC / 256) * 4, F.G, F.bx, (const char*)(ws + WS_O), (const char*)(ws + WS_WBR + (size_t)C.layer * 4 * 1024 * 256 * 2)};
    EpiGateChain E{(const unsigned char*)(ws + WS_GT), (bf16*)(ws + WS_MG)};
    pg8::gemm_phase(F.lds, F.tid, 1024, 256, 256, Sb, E); }
SITE(site_out) {
    SchedDense Sd; Sd.init(TC / 256, 4, F.G, F.bx, ws + WS_MG, (size_t)256 * 1024 * 2, ws + WS_WOUT + (size_t)C.layer * 1024 * 1024 * 2, (size_t)256 * 1024 * 2);
    EpiResGate E{C.xin, (const bf16*)(ws + WS_XB), (bf16*)(ws + WS_XB), C.modl + 2048};
    pg8::gemm_phase(F.lds, F.tid, 1024, 1024, 1024, Sd, E); }
SITE(site_norm2) { norm_phase<true>(F, args, nullptr, (const bf16*)(ws + WS_XB), C.chunk, C.layer); }
SITE(site_moeup) {
    moe_tables(F, C.chunk * NL + C.layer);
    SchedMoeUp Sm{F.G, F.bx, (const char*)(ws + WS_H), (const char*)(ws + WS_WGU + (size_t)C.layer * NEXP1 * 512 * 1024 * 2), (const LAS int*)(F.lds + MOET_OFF) + 16};
    moe_fill_rows(F, Sm);
    EpiSwiGLU E{(bf16*)(ws + WS_HID)};
    pg8::gemm_phase<EpiSwiGLU, SchedMoeUp, true>(F.lds, F.tid, 1024, 1024, 1024, Sm, E, (const LAS int*)(F.lds + ROWS_OFF)); }
SITE(site_moedn) {
    moe_tables(F, C.chunk * NL + C.layer);
    SchedMoeDn Sm{F.G, F.bx, (const char*)(ws + WS_HID), (const char*)(ws + WS_WD + (size_t)C.layer * NEXP1 * 1024 * 256 * 2), (const LAS int*)(F.lds + MOET_OFF) + 16};
    EpiStore E{(bf16*)(ws + WS_YBUF), 1024, 1 << 30, 1.0f};
    pg8::gemm_phase(F.lds, F.tid, 256, 256, 256, Sm, E); }
SITE(site_moeout) {
    moe_tables(F, C.chunk * NL + C.layer);
    SchedDense Sd; Sd.init(TC / 256, 4, F.G, F.bx, ws + WS_HID, (size_t)256 * 256 * 2, ws + WS_WD + ((size_t)C.layer * NEXP1 + 16) * 1024 * 256 * 2, (size_t)256 * 256 * 2);
    EpiMoeOut E{(const bf16*)(ws + WS_XB), (bf16*)(ws + WS_XB), (C.layer == NL - 1) ? C.xout : nullptr, C.modl + 5120, (const bf16*)(ws + WS_YBUF), (const int*)(ws + WS_TOKPOS), (const float*)(ws + WS_TOKW), (const LAS int*)(F.lds + MOET_OFF) + 16};
    pg8::gemm_phase(F.lds, F.tid, 256, 256, 256, Sd, E); }

template <int DUMMY>
DI void layer_body(Frame& F, const Args& args, unsigned char*& ws, const XcdBarrier& bar, const int chunk, const int layer) {
#define GRID_BAR() do { if (args.one) xcd_barrier(bar); } while (0)
#define IN(k) ((ONLY_PH < 0 || ONLY_PH == (k)) && args.ph_lo <= (k) && (k) < args.ph_hi && launder(F, ws, args.ws))
#define RUN(k, fn) do { if (IN(k)) { fn(F, args, ws, C); GRID_BAR(); } if (((PROBE_DOUBLE >> (k)) & 1) && IN(k)) { fn(F, args, ws, C); GRID_BAR(); } } while (0)
    Ctx C; C.chunk = chunk; C.layer = layer;
    C.xout = args.out + (size_t)chunk * TC * D;
    C.xin = (layer == 0) ? inp(F, 0) + (size_t)chunk * TC * D : nullptr;
    C.modl = (const float*)(args.ws + WS_MOD) + ((size_t)layer * NB + chunk * NBC) * 6144;
    RUN(PH_NORM1, site_norm1); RUN(PH_INPROJ, site_inproj); RUN(PH_PREP1, site_prep1); RUN(PH_MLAG, site_mlag); RUN(PH_PREP2, site_prep2); RUN(PH_ATTN, site_attn);
    RUN(PH_BRANCH, site_branch); RUN(PH_OUT, site_out); RUN(PH_NORM2, site_norm2); RUN(PH_MOEUP, site_moeup); RUN(PH_MOEDN, site_moedn); RUN(PH_MOEOUT, site_moeout);
#undef RUN
#undef IN
#undef GRID_BAR
}
__global__ void __launch_bounds__(NTHREADS, 2) trunk_fwd(Args args) {
    extern __shared__ __attribute__((aligned(16))) unsigned char lds_raw[];
    Frame F;
    F.lds = (LAS unsigned char*)lds_raw;
    F.tid = threadIdx.x; F.lane = F.tid & 63; F.wave = __builtin_amdgcn_readfirstlane(F.tid >> 6);
    F.G = gridDim.x; F.bx = blockIdx.x; F.ws = args.ws;
    unsigned char* ws = args.ws;
    gu32* ctl = (gu32*)(ws + WS_CTL);
    volatile LAS unsigned* MISC = (volatile LAS unsigned*)(F.lds + MISC_OFF);
    for (int u = F.tid; u < (LDS_BYTES - RING_BYTES) / 4; u += NTHREADS) ((LAS unsigned*)(F.lds + RING_BYTES))[u] = 0u;
    __syncthreads();
    if (F.tid == 0) {
#pragma unroll
        for (int k = 0; k < 30; ++k) ((volatile LAS unsigned long long*)(F.lds + PTAB_OFF))[k] = (unsigned long long)args.in[k];
    }
    __syncthreads();
    XcdBarrier bar; bar.bar = (unsigned*)(ctl + CW_BAR); bar.x = 0; bar.st = nullptr;
    if (args.one) bar = xcd_barrier_post((unsigned*)(ctl + CW_BAR), MISC + 8);
#define GRID_BAR() do { if (args.one) xcd_barrier(bar); } while (0)

    if ((ONLY_PH_P0) && args.ph_lo <= 0) { p0_prologue(F, args); GRID_BAR(); }
    if ((PROBE_DOUBLE & 1) && args.ph_lo <= 0) { launder(F, ws, args.ws); p0_prologue(F, args); GRID_BAR(); }

#if MK_MULTI
    layer_body<0>(F, args, ws, bar, args.c_lo, args.l_lo);
#else
    layer_body<0>(F, args, ws, bar, 0, 0); layer_body<1>(F, args, ws, bar, 0, 1); layer_body<2>(F, args, ws, bar, 0, 2); layer_body<3>(F, args, ws, bar, 0, 3);
    layer_body<4>(F, args, ws, bar, 1, 0); layer_body<5>(F, args, ws, bar, 1, 1); layer_body<6>(F, args, ws, bar, 1, 2); layer_body<7>(F, args, ws, bar, 1, 3);
#endif
}

extern "C" void kernel_launch(void* const* d_in, const int* in_sizes, int n_in, void* d_out, int out_size, void* d_ws, size_t ws_size, hipStream_t stream) {
    static int grid = 0;
    if (grid == 0) {
        if (n_in != 30 || in_sizes[0] != NB * S * D || out_size != NB * S * D || ws_size < WS_END) { fprintf(stderr, "kernel_launch: unexpected shapes / workspace (n_in %d, ws %zu)\n", n_in, ws_size); grid = -1; return; }
        int dev = 0, cus = 0, per_cu = 0;
        if (hipGetDevice(&dev) != hipSuccess || hipDeviceGetAttribute(&cus, hipDeviceAttributeMultiprocessorCount, dev) != hipSuccess) { grid = -1; return; }
        if (hipFuncSetAttribute((const void*)trunk_fwd, hipFuncAttributeMaxDynamicSharedMemorySize, LDS_BYTES) != hipSuccess) { fprintf(stderr, "kernel_launch: hipFuncSetAttribute failed\n"); grid = -1; return; }
        if (hipOccupancyMaxActiveBlocksPerMultiprocessor(&per_cu, (const void*)trunk_fwd, NTHREADS, LDS_BYTES) != hipSuccess || per_cu < 1) fprintf(stderr, "kernel_launch: occupancy query reports %d\n", per_cu);
        (void)hipGetLastError();
        grid = cus;
    }
    if (grid < 0) return;
    (void)hipMemsetAsync((char*)d_ws + WS_CTL, 0, CTL_ZERO_BYTES, stream);
    Args a{};
    for (int i = 0; i < 30; ++i) a.in[i] = (const float*)d_in[i];
    a.out = (float*)d_out; a.ws = (unsigned char*)d_ws;
#if MK_MULTI
    a.one = 0;
    a.c_lo = 0; a.c_hi = 0; a.l_lo = 0; a.l_hi = 0; a.ph_lo = 0; a.ph_hi = 1;
    hipLaunchKernelGGL(trunk_fwd, dim3(grid), dim3(NTHREADS), LDS_BYTES, stream, a);
    for (int c = 0; c < NCHUNK; ++c) for (int l = 0; l < NL; ++l) for (int ph = 1; ph < PH_END; ++ph) {
        a.c_lo = c; a.c_hi = c + 1; a.l_lo = l; a.l_hi = l + 1; a.ph_lo = ph; a.ph_hi = ph + 1;
        hipLaunchKernelGGL(trunk_fwd, dim3(grid), dim3(NTHREADS), LDS_BYTES, stream, a);
    }
#else
    a.one = 1; a.c_lo = 0; a.c_hi = NCHUNK; a.l_lo = 0; a.l_hi = NL; a.ph_lo = 0; a.ph_hi = PH_END;
    hipLaunchKernelGGL(trunk_fwd, dim3(grid), dim3(NTHREADS), LDS_BYTES, stream, a);
#endif
}
```

```cpp
#include <hip/hip_runtime.h>
#include <cstdio>
#include <cstdint>

#define GAS __attribute__((address_space(1)))
#define LAS __attribute__((address_space(3)))
typedef unsigned short bf16;
typedef unsigned v4u __attribute__((ext_vector_type(4)));
typedef unsigned v2u __attribute__((ext_vector_type(2)));
typedef float f32x2 __attribute__((ext_vector_type(2)));
typedef float f32x4 __attribute__((ext_vector_type(4)));
typedef float f32x16 __attribute__((ext_vector_type(16)));
typedef short bf16x8 __attribute__((ext_vector_type(8)));
typedef short s16x4 __attribute__((ext_vector_type(4)));
typedef GAS unsigned gu32;
#define RLX_AGENT __ATOMIC_RELAXED, __HIP_MEMORY_SCOPE_AGENT
#define DI __device__ __forceinline__

DI unsigned cvt_pk_bf16(float lo, float hi) { unsigned r; asm volatile("v_cvt_pk_bf16_f32 %0, %1, %2" : "=v"(r) : "v"(lo), "v"(hi)); return r; }
DI float bf_lo(unsigned u) { return __uint_as_float(u << 16); }
DI float bf_hi(unsigned u) { return __uint_as_float(u & 0xffff0000u); }
DI float bf2f(bf16 b) { return __uint_as_float(((unsigned)b) << 16); }
DI float fast_exp2(float x) { return __builtin_amdgcn_exp2f(x); }
DI float fast_log2(float x) { return __builtin_amdgcn_logf(x); }
DI float fast_rcp(float x) { return __builtin_amdgcn_rcpf(x); }
DI float sigmoid_f(float v) { return fast_rcp(1.0f + fast_exp2(-1.4426950408889634f * v)); }
DI unsigned pk4_fp8(float a, float b, float c, float d) { int p = 0; p = __builtin_amdgcn_cvt_pk_fp8_f32(a, b, p, false); p = __builtin_amdgcn_cvt_pk_fp8_f32(c, d, p, true); return (unsigned)p; }
DI f32x4 unpk4_fp8(unsigned u) { const f32x2 lo = __builtin_amdgcn_cvt_pk_f32_fp8((int)u, false), hi = __builtin_amdgcn_cvt_pk_f32_fp8((int)u, true); return (f32x4){lo.x, lo.y, hi.x, hi.y}; }
DI float wave_sum(float v) {
#pragma unroll
    for (int o = 1; o < 64; o <<= 1) v += __shfl_xor(v, o);
    return v;
}

namespace pg8 {
#define PG8_LAS __attribute__((address_space(3)))
typedef unsigned short bf16_t;
constexpr int BM = 256, BK = 64, HALF = 128, HTB = HALF * BK * 2, STAGE_BYTES = 8 * HTB;

__host__ __device__ __forceinline__ int lds_byte(int r, int c) { const int st = (r >> 4) * 2 + (c >> 5), rr = r & 15, cc = c & 31, ob = rr * 64 + cc * 2; return st * 1024 + (ob ^ (((ob >> 9) & 1) << 5)); }
__host__ __device__ __forceinline__ void stage_rc(int b, int& R, int& C) { const int st = b / 1024, sb = b % 1024, swz = sb ^ (((sb >> 9) & 1) << 5); R = (st >> 1) * 16 + swz / 64; C = (st & 1) * 32 + (swz % 64) / 2; }
__host__ __device__ __forceinline__ int perm32(int rho) { const int n = rho >> 4, i = rho & 15; return 8 * (i >> 2) + 4 * n + (i & 3); }

struct Unit { int pm, pn, aux; const char* pa; const char* pb; };
__device__ __forceinline__ const char* uni_ptr(const char* p) { const unsigned long long v = (unsigned long long)p; const unsigned lo = __builtin_amdgcn_readfirstlane((unsigned)v), hi = __builtin_amdgcn_readfirstlane((unsigned)(v >> 32)); return (const char*)(((unsigned long long)hi << 32) | lo); }

typedef f32x4 Acc[2][2][4][2];

template <class Epi, class Sched, bool GATHER = false>
__device__ __forceinline__ void gemm_phase(PG8_LAS unsigned char* lds, const int tid, const int lda, const int ldb, const int K, const Sched& S, const Epi& E, const PG8_LAS int* rows = nullptr) {
    const int wid = __builtin_amdgcn_readfirstlane(tid >> 6), lane = tid & 63, wr = wid >> 2, wc = wid & 3, fr = lane & 15, fq = lane >> 4;
    int nt = K / BK; asm volatile("" : "+s"(nt));
    unsigned voffA[2], voffB[2];
#pragma unroll
    for (int i = 0; i < 2; ++i) { int R, C; stage_rc(tid * 16 + i * 8192, R, C); const int Rb = Epi::PERM ? ((R & ~31) + perm32(R & 31)) : R;
        voffA[i] = (unsigned)(R * lda + C) * 2u; voffB[i] = (unsigned)(Rb * ldb + C) * 2u; }
    unsigned cvA[2][2], nvA[2][2];
#define PG8_GOFFS(dst, uidx) do { _Pragma("unroll") for (int _h = 0; _h < 2; ++_h) _Pragma("unroll") for (int _i = 0; _i < 2; ++_i) { int R_, C_; stage_rc(tid * 16 + _i * 8192, R_, C_); \
        dst[_h][_i] = (unsigned)(rows[(uidx) * 256 + _h * 128 + R_] * lda + C_) * 2u; } } while (0)
#define PG8_STAGE_A(bufoff, gbase, half, offs) do { if constexpr (GATHER) { PG8_STAGE(bufoff, gbase, offs[half]); } else { PG8_STAGE(bufoff, (gbase) + ((half) ? hstepA : 0), voffA); } } while (0)
    const size_t kstep = (size_t)(BK * 2);
    const size_t hstepA = (size_t)HALF * lda * 2, hstepB = (size_t)HALF * ldb * 2;
    const unsigned ldsw = (unsigned)wid * 1024u;
    const int aoff = lds_byte(wr * 64 + fr, fq * 8), boff = lds_byte(wc * 32 + fr, fq * 8);
#define PG8_SA(b, h) (((b) * 2 + (h)) * HTB)
#define PG8_SB(b, h) ((4 + (b) * 2 + (h)) * HTB)
#define PG8_STAGE(bufoff, gbase, voff) do { _Pragma("unroll") for (int _i = 0; _i < 2; ++_i) \
        __builtin_amdgcn_global_load_lds((const unsigned*)((const char*)(gbase) + (voff)[_i]), (PG8_LAS unsigned*)(lds + (bufoff) + ldsw + _i * 8192), 16, 0, 0); } while (0)
#define PG8_LDA(dst, b, h) do { _Pragma("unroll") for (int m = 0; m < 4; ++m) _Pragma("unroll") for (int k = 0; k < 2; ++k) dst[m][k] = *(const PG8_LAS bf16x8*)(lds + PG8_SA(b, h) + aoff + m * 2048 + k * 1024); } while (0)
#define PG8_LDB(dst, b, h) do { _Pragma("unroll") for (int n = 0; n < 2; ++n) _Pragma("unroll") for (int k = 0; k < 2; ++k) dst[n][k] = *(const PG8_LAS bf16x8*)(lds + PG8_SB(b, h) + boff + n * 2048 + k * 1024); } while (0)
#define PG8_MMA(ai, bj, At, Bt) do { __builtin_amdgcn_s_setprio(1); _Pragma("unroll") for (int m = 0; m < 4; ++m) _Pragma("unroll") for (int n = 0; n < 2; ++n) _Pragma("unroll") for (int k = 0; k < 2; ++k) \
        acc[ai][bj][m][n] = __builtin_amdgcn_mfma_f32_16x16x32_bf16(Bt[n][k], At[m][k], acc[ai][bj][m][n], 0, 0, 0); __builtin_amdgcn_s_setprio(0); } while (0)
#define PG8_WAIT_V(n) asm volatile("s_waitcnt vmcnt(" #n ")" ::: "memory")
#define PG8_WAIT_L(n) asm volatile("s_waitcnt lgkmcnt(" #n ")" ::: "memory")
#define PG8_BAR __builtin_amdgcn_s_barrier()
#define PG8_SCHED __builtin_amdgcn_sched_barrier(0)
    Unit cur, nxt; int ui = 0;
    if (!S.next(0, cur)) return;
    Acc acc;
#pragma unroll
    for (int a = 0; a < 2; ++a)
#pragma unroll
        for (int b = 0; b < 2; ++b)
#pragma unroll
            for (int m = 0; m < 4; ++m)
#pragma unroll
                for (int n = 0; n < 2; ++n) acc[a][b][m][n] = (f32x4){0.f, 0.f, 0.f, 0.f};
    bf16x8 At[4][2], B0[2][2], B1[2][2];
    const char* cA = cur.pa; const char* cB = cur.pb;
    if constexpr (GATHER) { PG8_GOFFS(cvA, 0); }
    PG8_STAGE(PG8_SB(0, 0), cB, voffB); PG8_STAGE(PG8_SB(0, 1), cB + hstepB, voffB); PG8_STAGE_A(PG8_SA(0, 0), cA, 0, cvA); PG8_STAGE_A(PG8_SA(0, 1), cA, 1, cvA);
    if (wr == 1) PG8_BAR;
    PG8_WAIT_V(2); PG8_BAR;
    PG8_STAGE(PG8_SB(1, 0), cB + kstep, voffB); PG8_STAGE_A(PG8_SA(1, 0), cA + kstep, 0, cvA); PG8_STAGE(PG8_SB(1, 1), cB + hstepB + kstep, voffB);
    PG8_WAIT_V(6); PG8_BAR;
    for (;;) {
        const bool has_next = S.next(ui + 1, nxt);
        const char* nA = has_next ? nxt.pa : cA; const char* nB = has_next ? nxt.pb : cB;
        if constexpr (GATHER) { if (has_next) { PG8_GOFFS(nvA, ui + 1); } else { _Pragma("unroll") for (int _h = 0; _h < 2; ++_h) _Pragma("unroll") for (int _i = 0; _i < 2; ++_i) nvA[_h][_i] = cvA[_h][_i]; } }
#pragma nounroll
        for (int t = 0; t < nt; t += 2) {
            const bool last = (t == nt - 2);
            const char* a1 = cA + (size_t)(t + 1) * kstep;
            const char* a2 = last ? nA : cA + (size_t)(t + 2) * kstep; const char* b2 = last ? nB : cB + (size_t)(t + 2) * kstep;
            const char* a3 = a2 + kstep; const char* b3 = b2 + kstep;
            PG8_LDB(B0, 0, 0); PG8_LDB(B1, 0, 1); PG8_SCHED; PG8_LDA(At, 0, 0); PG8_STAGE_A(PG8_SA(1, 1), a1, 1, cvA);
            PG8_WAIT_V(8); PG8_WAIT_L(0); PG8_BAR; PG8_MMA(0, 0, At, B0); PG8_MMA(0, 1, At, B1); PG8_BAR; PG8_SCHED;
            PG8_LDA(At, 0, 1); PG8_STAGE(PG8_SB(0, 0), b2, voffB); PG8_STAGE(PG8_SB(0, 1), b2 + hstepB, voffB); if (last) { PG8_STAGE_A(PG8_SA(0, 0), a2, 0, nvA); } else { PG8_STAGE_A(PG8_SA(0, 0), a2, 0, cvA); }
            PG8_WAIT_V(8); PG8_WAIT_L(0); PG8_BAR; PG8_MMA(1, 0, At, B0); PG8_MMA(1, 1, At, B1); PG8_BAR; PG8_SCHED;
            PG8_LDB(B0, 1, 0); PG8_LDB(B1, 1, 1); PG8_SCHED; PG8_LDA(At, 1, 0); if (last) { PG8_STAGE_A(PG8_SA(0, 1), a2, 1, nvA); } else { PG8_STAGE_A(PG8_SA(0, 1), a2, 1, cvA); }
            PG8_WAIT_V(8); PG8_WAIT_L(0); PG8_BAR; PG8_MMA(0, 0, At, B0); PG8_MMA(0, 1, At, B1); PG8_BAR; PG8_SCHED;
            PG8_LDA(At, 1, 1); PG8_STAGE(PG8_SB(1, 0), b3, voffB); PG8_STAGE(PG8_SB(1, 1), b3 + hstepB, voffB); if (last) { PG8_STAGE_A(PG8_SA(1, 0), a3, 0, nvA); } else { PG8_STAGE_A(PG8_SA(1, 0), a3, 0, cvA); }
            PG8_WAIT_V(8); PG8_WAIT_L(0); PG8_BAR; PG8_MMA(1, 0, At, B0); PG8_MMA(1, 1, At, B1); PG8_BAR; PG8_SCHED;
        }
        if (wr == 0) PG8_BAR;
        E(acc, cur, has_next, nxt, wr, wc, fr, fq);
        if (!has_next) break;
        if constexpr (!Epi::CHAIN) {
#pragma unroll
            for (int a = 0; a < 2; ++a)
#pragma unroll
                for (int b = 0; b < 2; ++b)
#pragma unroll
                    for (int m = 0; m < 4; ++m)
#pragma unroll
                        for (int n = 0; n < 2; ++n) acc[a][b][m][n] = (f32x4){0.f, 0.f, 0.f, 0.f};
        }
        cur = nxt; cA = nA; cB = nB; ++ui;
        if constexpr (GATHER) { _Pragma("unroll") for (int _h = 0; _h < 2; ++_h) _Pragma("unroll") for (int _i = 0; _i < 2; ++_i) cvA[_h][_i] = nvA[_h][_i]; }
        if (wr == 1) PG8_BAR;
    }
    PG8_WAIT_V(0);
    PG8_BAR;
#undef PG8_SA
#undef PG8_SB
#undef PG8_STAGE
#undef PG8_STAGE_A
#undef PG8_GOFFS
#undef PG8_LDA
#undef PG8_LDB
#undef PG8_MMA
#undef PG8_WAIT_V
#undef PG8_WAIT_L
#undef PG8_BAR
#undef PG8_SCHED
}
}

namespace g8 {
using pg8::lds_byte; using pg8::stage_rc; using pg8::perm32;
typedef int v4i_t __attribute__((ext_vector_type(4)));
typedef int v8i_t __attribute__((ext_vector_type(8)));
constexpr int HTB = 16384;
__device__ __forceinline__ void gate_gemm_fp8(LAS unsigned char* lds, const int tid, const int G, const int c, const unsigned char* A8, const unsigned char* B8, unsigned char* GT, const float scale, const int nMtiles, const int nheavy) {
    const int wid = __builtin_amdgcn_readfirstlane(tid >> 6), lane = tid & 63, wr = wid >> 2, wc = wid & 3, fr = lane & 15, fq = lane >> 4;
    constexpr int KB = 1024, NT = KB / 128;
    const bool deal79 = (G == 256 && nMtiles == 128 && nheavy == 128);
    const int gq = c >> 4;
    const int nun = deal79 ? (gq < 8 ? 7 : 9) : ((nMtiles * 16 > c) ? (nMtiles * 16 - c + G - 1) / G : 0);
    const int pm0 = deal79 ? (gq < 8 ? gq * 7 : 56 + (gq - 8) * 9) : 0;
    if (nun == 0) return;
    const int total = nun * NT;
    unsigned voffA, voffB;
    { int R, C; stage_rc(tid * 16, R, C); const int Rb = (R & ~31) + perm32(R & 31); voffA = (unsigned)(R * KB + 2 * C); voffB = (unsigned)(Rb * KB + 2 * C); }
    const unsigned ldsw = (unsigned)wid * 1024u;
    const int aoff = lds_byte(wr * 64 + fr, fq * 8), boff = lds_byte(wc * 32 + fr, fq * 8);
#define G8_DMA2(bufoff, gbase, o0) do { __builtin_amdgcn_global_load_lds((const unsigned*)((const char*)(gbase) + (o0)), (LAS unsigned*)(lds + (bufoff) + ldsw), 16, 0, 0); \
        __builtin_amdgcn_global_load_lds((const unsigned*)((const char*)(gbase) + ((o0) + 64u * KB)), (LAS unsigned*)(lds + (bufoff) + ldsw + 8192), 16, 0, 0); } while (0)
#define G8_ISSUE(s) do { const int u_ = (s) / NT, kt_ = (s) % NT, b_ = (s) & 1; const long L_ = (long)u_ * G + c; const int pm_ = deal79 ? pm0 + u_ : (int)(L_ >> 4), pn_ = deal79 ? (c & 15) : (int)(L_ & 15); \
        const unsigned char* pa_ = (const unsigned char*)pg8::uni_ptr((const char*)A8 + (size_t)pm_ * 256 * KB + kt_ * 128); const unsigned char* pb_ = (const unsigned char*)pg8::uni_ptr((const char*)B8 + (size_t)pn_ * 256 * KB + kt_ * 128); \
        G8_DMA2((b_ * 4 + 2) * HTB, pb_, voffB); G8_DMA2((b_ * 4 + 3) * HTB, pb_, voffB + 128u * KB); G8_DMA2((b_ * 4 + 0) * HTB, pa_, voffA); G8_DMA2((b_ * 4 + 1) * HTB, pa_, voffA + 128u * KB); } while (0)
#define G8_RD(off) (*(const LAS bf16x8*)(lds + (off)))
#define G8_CAT(x, y) __builtin_shufflevector(__builtin_bit_cast(v4i_t, (x)), __builtin_bit_cast(v4i_t, (y)), 0, 1, 2, 3, 4, 5, 6, 7)
#define G8_MMA(ai, A8f) do { __builtin_amdgcn_s_setprio(1); _Pragma("unroll") for (int m = 0; m < 4; ++m) _Pragma("unroll") for (int n = 0; n < 2; ++n) { \
        acc[ai][0][m][n] = __builtin_amdgcn_mfma_scale_f32_16x16x128_f8f6f4(B0f[n], A8f[m], acc[ai][0][m][n], 0, 0, 0, 0, 0, 0); \
        acc[ai][1][m][n] = __builtin_amdgcn_mfma_scale_f32_16x16x128_f8f6f4(B1f[n], A8f[m], acc[ai][1][m][n], 0, 0, 0, 0, 0, 0); } __builtin_amdgcn_s_setprio(0); } while (0)
    f32x4 acc[2][2][4][2];
#pragma unroll
    for (int a = 0; a < 2; ++a)
#pragma unroll
        for (int b = 0; b < 2; ++b)
#pragma unroll
            for (int m = 0; m < 4; ++m)
#pragma unroll
                for (int n = 0; n < 2; ++n) acc[a][b][m][n] = (f32x4){0.f, 0.f, 0.f, 0.f};
    G8_ISSUE(0);
    if (total > 1) G8_ISSUE(1);
#pragma nounroll
    for (int s = 0; s < total; ++s) {
        const int b = s & 1;
        if (s + 1 < total && (s % NT) != 0) asm volatile("s_waitcnt vmcnt(8)" ::: "memory"); else asm volatile("s_waitcnt vmcnt(0)" ::: "memory");
        __builtin_amdgcn_s_barrier();
        asm volatile("" ::: "memory");
        v8i_t A8f[4], A8g[4], B0f[2], B1f[2];
        { const int ab = (b * 4) * HTB + aoff, bb = (b * 4 + 2) * HTB + boff;
#pragma unroll
          for (int n = 0; n < 2; ++n) { B0f[n] = G8_CAT(G8_RD(bb + n * 2048), G8_RD(bb + n * 2048 + 1024)); B1f[n] = G8_CAT(G8_RD(bb + HTB + n * 2048), G8_RD(bb + HTB + n * 2048 + 1024)); }
#pragma unroll
          for (int m = 0; m < 4; ++m) { A8f[m] = G8_CAT(G8_RD(ab + m * 2048), G8_RD(ab + m * 2048 + 1024)); A8g[m] = G8_CAT(G8_RD(ab + HTB + m * 2048), G8_RD(ab + HTB + m * 2048 + 1024)); } }
        asm volatile("s_waitcnt lgkmcnt(0)" ::: "memory");
        __builtin_amdgcn_s_barrier();
        asm volatile("" ::: "memory");
        if (s + 2 < total) G8_ISSUE(s + 2);
        G8_MMA(0, A8f);
        G8_MMA(1, A8g);
        if ((s % NT) == NT - 1) {
            const int u_ = s / NT; const long L_ = (long)u_ * G + c; const int pm_ = __builtin_amdgcn_readfirstlane(deal79 ? pm0 + u_ : (int)(L_ >> 4)), pn_ = __builtin_amdgcn_readfirstlane(deal79 ? (c & 15) : (int)(L_ & 15));
            const int c4 = 64 * pn_ + 16 * wc + 4 * fq;
            const int pno = c4 >> 8, bjc = (c4 >> 7) & 1, wcc = (c4 >> 5) & 3, fqc = (c4 >> 3) & 3, half = (c4 >> 2) & 1;
            unsigned char* tp = GT + ((size_t)(pm_ * 4 + pno) * 65536) + (size_t)((wr * 4 + wcc) * 64 + fqc * 16 + fr) * 8 + half * 4;
            const size_t BR = (size_t)nMtiles * 4 * 65536;
            const float nscale = -1.4426950408889634f * scale;
#pragma unroll
            for (int ai = 0; ai < 2; ++ai)
#pragma unroll
                for (int m = 0; m < 4; ++m) {
                    f32x4 g[4], d[4];
#pragma unroll
                    for (int q = 0; q < 4; ++q) { const f32x4 t = __builtin_elementwise_min(acc[ai][q >> 1][m][q & 1] * nscale, (f32x4){64.f, 64.f, 64.f, 64.f});
                        d[q] = (f32x4){1.0f + fast_exp2(t[0]), 1.0f + fast_exp2(t[1]), 1.0f + fast_exp2(t[2]), 1.0f + fast_exp2(t[3])};
                        g[q] = (f32x4){fast_rcp(d[q][0]), fast_rcp(d[q][1]), fast_rcp(d[q][2]), fast_rcp(d[q][3])};
                        acc[ai][q >> 1][m][q & 1] = (f32x4){0.f, 0.f, 0.f, 0.f}; }
                    unsigned char* sp = tp + (size_t)(((ai * 4 + m) * 2 + bjc) * 512) * 8;
#pragma unroll
                    for (int q = 0; q < 4; ++q) { f32x4 r = (q < 3) ? g[q] * d[q + 1] : g[q];
                        r = __builtin_elementwise_min(r, (f32x4){448.f, 448.f, 448.f, 448.f}); *(unsigned*)(sp + q * BR) = pk4_fp8(r[0], r[1], r[2], r[3]); }
                }
        }
    }
    asm volatile("s_waitcnt vmcnt(0)" ::: "memory");
    __builtin_amdgcn_s_barrier();
#undef G8_DMA2
#undef G8_ISSUE
#undef G8_RD
#undef G8_CAT
#undef G8_MMA
}
}
#define XB_TMO      128
#define XB_XCNT(j)  (256  + 64 * (j))
#define XB_XSUB(j)  (1280 + 64 * (j))
#define XB_XGEN(j)  (2304 + 64 * (j))
#define XB_TOP      3328
#define XB_TOPGEN   3392
#define XCD_BAR_WORDS 3456
#define XB_SPIN_CAP (1u << 18)

__device__ __forceinline__ unsigned xb_ld(unsigned* p)              { return __hip_atomic_load(p, __ATOMIC_RELAXED, __HIP_MEMORY_SCOPE_AGENT); }
__device__ __forceinline__ unsigned xb_add(unsigned* p, unsigned v) { return __hip_atomic_fetch_add(p, v, __ATOMIC_RELAXED, __HIP_MEMORY_SCOPE_AGENT); }
__device__ __forceinline__ unsigned xb_xcc_id() { return (unsigned)__builtin_amdgcn_s_getreg((3 << 11) | 20) & 0xFu; }
#define XB_SPIN(cond, bar) do { unsigned _sp = 0; while (cond) { __builtin_amdgcn_s_sleep(1); \
    if ((++_sp & 255u) == 0u) { if (xb_ld(&(bar)[XB_TMO])) break; if (_sp > XB_SPIN_CAP) { atomicAdd(&(bar)[XB_TMO], 1u); break; } } } } while (0)

struct XcdBarrier {
    unsigned* bar; unsigned x;
    volatile LAS unsigned* st;
};

__device__ __forceinline__ XcdBarrier xcd_barrier_post(unsigned* bar, volatile LAS unsigned* st) {
    XcdBarrier b; b.bar = bar; b.x = xb_xcc_id(); b.st = st;
    if (threadIdx.x == 0) (void)xb_add(&bar[XB_XCNT(b.x)], 1u);
    return b;
}
__device__ __forceinline__ void xcd_barrier_complete(unsigned* bar, unsigned x, unsigned& nloc, unsigned& nx) {
    const unsigned G = gridDim.x * gridDim.y * gridDim.z;
    unsigned sum, cnt, mine, sp = 0u;
    for (;;) {
        sum = 0u; cnt = 0u; mine = 0u;
#pragma unroll
        for (unsigned j = 0; j < 16; ++j) { const unsigned c = xb_ld(&bar[XB_XCNT(j)]); sum += c; cnt += (c > 0u) ? 1u : 0u; mine = (j == x) ? c : mine; }
        if (sum == G) break;
        __builtin_amdgcn_s_sleep(1);
        if ((++sp & 255u) == 0u) { if (xb_ld(&bar[XB_TMO])) break; if (sp > XB_SPIN_CAP) { atomicAdd(&bar[XB_TMO], 1u); break; } }
    }
    nloc = mine > 0u ? mine : 1u; nx = cnt > 0u ? cnt : 1u;
}

__device__ __forceinline__ void xcd_barrier(const XcdBarrier& b) {
    asm volatile("s_waitcnt vmcnt(0)" ::: "memory");
    __syncthreads();
    if (threadIdx.x == 0) {
        unsigned* bar = b.bar;
        __builtin_amdgcn_s_waitcnt(0);
        unsigned nloc = b.st[0], nx = b.st[1];
        if (nloc == 0u) { xcd_barrier_complete(bar, b.x, nloc, nx); b.st[0] = nloc; b.st[1] = nx; }
        const unsigned old = xb_add(&bar[XB_XSUB(b.x)], 1u);
        const unsigned gen = old / nloc;
        if (old + 1u == (gen + 1u) * nloc) {
            __builtin_amdgcn_fence(__ATOMIC_RELEASE, "agent");
            asm volatile("s_waitcnt vmcnt(0)" ::: "memory");
            const unsigned og = xb_add(&bar[XB_TOP], 1u);
            const unsigned tg = og / nx;
            if (og + 1u == (tg + 1u) * nx) xb_add(&bar[XB_TOPGEN], 1u);
            else XB_SPIN(xb_ld(&bar[XB_TOPGEN]) == tg, bar);
            __builtin_amdgcn_fence(__ATOMIC_ACQUIRE, "agent");
            xb_add(&bar[XB_XGEN(b.x)], 1u);
            asm volatile("s_waitcnt vmcnt(0)" ::: "memory");
        } else {
            XB_SPIN(xb_ld(&bar[XB_XGEN(b.x)]) == gen, bar);
            __builtin_amdgcn_fence(__ATOMIC_ACQUIRE, "agent");
            asm volatile("s_waitcnt vmcnt(0)" ::: "memory");
        }
    }
    __syncthreads();
}

constexpr int NB = 32, S = 2048, D = 1024, NL = 4;
constexpr int NBC = 16;
constexpr int NCHUNK = NB / NBC;
constexpr int TC = NBC * S;
constexpr int NP = 6912;
constexpr int PS = 2816;
constexpr int IN_COLS = 6820;
constexpr int PA_Q = 0, PA_K = 256, PA_V = 512, PB_Q = 768, PB_K = 1024, PB_V = 1280, PD_Q = 1536, PD_K = 1792, PD_V = 2048;
constexpr int PC_CQ = 2304, PC_CKV = 2560, PC_KR = 2688, PC_FA = 2720, PG = 2816;
constexpr int NEXP = 16, NEXP1 = 17;
constexpr int RPAD = 2 * TC + 4096;
constexpr float LOG2E = 1.4426950408889634f;
constexpr float EPS = 1e-6f;

constexpr size_t MiB = 1u << 20, KiB = 1u << 10;
constexpr size_t WS_CTL = 0, CTL_ZERO_BYTES = 1 * MiB;
constexpr size_t WS_MOD = 1 * MiB;
constexpr size_t WS_TOKE = 4 * MiB;
constexpr size_t WS_TOKW = WS_TOKE + 256 * KiB;
constexpr size_t WS_TOKPOS = WS_TOKW + 256 * KiB;
constexpr size_t WS_CNT = WS_TOKPOS + 256 * KiB;
constexpr size_t WS_TILEEXP = WS_CNT + 32 * KiB;
constexpr size_t WS_LOGF = 5 * MiB;
constexpr size_t WS_ROPE = 6 * MiB;
constexpr size_t WS_LIST = 10 * MiB;
constexpr size_t WS_WIN = 12 * MiB;
constexpr size_t WS_WMLA = 66 * MiB;
constexpr size_t WS_WBR = 69 * MiB;
constexpr size_t WS_WOUT = 77 * MiB;
constexpr size_t WS_WGU = 85 * MiB;
constexpr size_t WS_WD = 153 * MiB;
constexpr size_t WS_H = 187 * MiB;
constexpr size_t WS_O = 251 * MiB;
constexpr size_t WS_MG = 315 * MiB;
constexpr size_t WS_QKVC = 379 * MiB;
constexpr size_t WS_QC = 443 * MiB;
constexpr size_t WS_KC = 467 * MiB;
constexpr size_t WS_PROJ = 491 * MiB;
constexpr size_t WS_GT = 667 * MiB;
constexpr size_t WS_HS = 491 * MiB;
constexpr size_t WS_HID = 627 * MiB;
constexpr size_t WS_YBUF = 677 * MiB;
constexpr size_t WS_XB = 923 * MiB;
constexpr size_t WS_H8 = 987 * MiB;
constexpr size_t WS_END = 1019 * MiB;
constexpr float WG8_SCALE = 64.0f;
static_assert(WS_PROJ + (size_t)TC * PS * 2 <= WS_GT && WS_GT + (size_t)4 * TC * 1024 * 2 <= WS_XB && WS_PROJ + (size_t)TC * PS * 2 <= WS_END && WS_HS + (size_t)RPAD * 1024 * 2 <= WS_HID && WS_HID + (size_t)(TC + RPAD) * 256 * 2 <= WS_YBUF && WS_YBUF + (size_t)RPAD * 1024 * 2 <= WS_XB, "ws map");
static_assert(WS_WIN + (size_t)NL * NP * 1024 * 2 <= WS_WMLA && WS_WGU + (size_t)NL * NEXP1 * 512 * 1024 * 2 <= WS_WD && WS_WD + (size_t)NL * NEXP1 * 1024 * 256 * 2 <= WS_H, "ws map 2");
constexpr int CW_TMO = 0, CW_BAR = 4096, CW_XRANK = 20480, CW_GCNT = 16384;
constexpr int NMT_WORD = 1000;

constexpr int RING_BYTES = 131072;
constexpr int MISC_OFF = RING_BYTES + 320;
constexpr int LDS_BYTES = 147456;
constexpr int NWAVES = 8, NTHREADS = 512;

struct Args {
    const float* in[30]; float* out; unsigned char* ws;
    int c_lo, c_hi, l_lo, l_hi, ph_lo, ph_hi, one, pad;
};

struct Frame {
    LAS unsigned char* lds;
    int tid, lane, wave, G, bx;
    unsigned char* ws;
};
constexpr int MOET_OFF = RING_BYTES + 1536;
constexpr int ROWS_OFF = RING_BYTES + 4096;
constexpr int PTAB_OFF = RING_BYTES + 1024;
DI const float* inp(const Frame& F, int k) {
    const unsigned long long v = ((volatile LAS unsigned long long*)(F.lds + PTAB_OFF))[k];
    const unsigned lo = __builtin_amdgcn_readfirstlane((unsigned)v), hi = __builtin_amdgcn_readfirstlane((unsigned)(v >> 32));
    return (const float*)(((unsigned long long)hi << 32) | lo);
}

struct MapIdent { int off; DI int operator()(int n) const { return off + n; } };
struct MapGate { int off; DI int operator()(int n) const { return (n >> 7) * 256 + off + (n & 127); } };
struct MapIn { DI int operator()(int s) const {
    if (s < 768) return s;
    if (s < 772) return PC_FA + (s - 768);
    if (s < 1540) return PB_Q + (s - 772);
    if (s < 1956) return PC_CQ + (s - 1540);
    if (s < 2724) return PD_Q + (s - 1956);
    return -1; } };

template <class Map> DI void tr_item(const float* W, int N, bf16* WT, int ldk, int koff, LAS float* scr, int k0, int n0, int lane, const Map map) {
    const int nn = n0 + (lane & 31);
    float tv[32];
#pragma unroll
    for (int i = 0; i < 32; ++i) { const int kk = 2 * i + (lane >> 5); tv[i] = (nn < N) ? W[(size_t)(k0 + kk) * N + nn] : 0.f; }
#pragma unroll
    for (int i = 0; i < 32; ++i) { const int kk = 2 * i + (lane >> 5); scr[kk * 33 + (lane & 31)] = tv[i]; }
    asm volatile("s_waitcnt lgkmcnt(0)" ::: "memory");
    const int c = lane & 7;
#pragma unroll
    for (int j = 0; j < 4; ++j) { const int nl = (lane >> 3) + 8 * j; const LAS float* s = scr + (8 * c) * 33 + nl;
        v4u o; o.x = cvt_pk_bf16(s[0 * 33], s[1 * 33]); o.y = cvt_pk_bf16(s[2 * 33], s[3 * 33]); o.z = cvt_pk_bf16(s[4 * 33], s[5 * 33]); o.w = cvt_pk_bf16(s[6 * 33], s[7 * 33]);
        const int dr = (n0 + nl < N) ? map(n0 + nl) : -1;
        if (dr >= 0) *(v4u*)(WT + (size_t)dr * ldk + koff + k0 + 8 * c) = o; }
    asm volatile("s_waitcnt lgkmcnt(0)" ::: "memory");
}

DI void tr_item8(const float* W, int N, unsigned char* WT8, int ldk, LAS float* scr, int k0, int n0, int nbase, int lane, float scale) {
    const int nn = n0 + (lane & 31);
    float tv[32];
#pragma unroll
    for (int i = 0; i < 32; ++i) { const int kk = 2 * i + (lane >> 5); tv[i] = (nn < N) ? W[(size_t)(k0 + kk) * N + nn] : 0.f; }
#pragma unroll
    for (int i = 0; i < 32; ++i) { const int kk = 2 * i + (lane >> 5); scr[kk * 33 + (lane & 31)] = tv[i] * scale; }
    asm volatile("s_waitcnt lgkmcnt(0)" ::: "memory");
    const int c = lane & 7;
#pragma unroll
    for (int j = 0; j < 4; ++j) { const int nl = (lane >> 3) + 8 * j; const LAS float* s = scr + (8 * c) * 33 + nl;
        v2u o; o.x = pk4_fp8(s[0 * 33], s[1 * 33], s[2 * 33], s[3 * 33]); o.y = pk4_fp8(s[4 * 33], s[5 * 33], s[6 * 33], s[7 * 33]);
        if (n0 + nl < N) { const int gi = n0 + nl - nbase, b = gi >> 10, cc = gi & 1023;
            const int row = (cc >> 6) * 256 + 128 * (b >> 1) + 32 * ((cc >> 4) & 3) + 8 * ((cc >> 2) & 3) + 4 * (b & 1) + (cc & 3);
            *(v2u*)(WT8 + (size_t)row * ldk + k0 + 8 * c) = o; } }
    asm volatile("s_waitcnt lgkmcnt(0)" ::: "memory");
}

constexpr int I_G8 = 16 * 128;
constexpr int I_IN = 16 * 214, I_UQ = 48, I_UKV = 32, I_BR = 512, I_OUT = 512, I_G = NEXP1 * 128, I_DN = NEXP1 * 128;
constexpr int NITEM_L = I_IN + I_UQ + I_UKV + I_BR + I_OUT + 2 * I_G + I_DN + I_G8;

DI void p0_prologue(const Frame& F, const Args& A) {
    unsigned char* ws = F.ws;
    {
        LAS float* condL = (LAS float*)F.lds;
        const float* c = inp(F, 1);
        for (int idx = F.tid; idx < NB * D; idx += NTHREADS) { const float v = c[idx]; const int b = idx >> 10, k = idx & 1023; condL[k * 32 + b] = v * sigmoid_f(v); }
        __syncthreads();
        const float* w_ada = inp(F, 5); const float* b_ada = inp(F, 6); float* MOD = (float*)(ws + WS_MOD);
        const int gw = F.bx * NWAVES + F.wave, NGW = F.G * NWAVES;
        for (int u = gw; u < NL * 384; u += NGW) {
            const int l = u / 384, j0 = (u % 384) * 16, col = F.lane & 15, ks = F.lane >> 4;
            float acc[32];
#pragma unroll
            for (int b = 0; b < 32; ++b) acc[b] = 0.f;
            const float* wp = w_ada + ((size_t)l * D + ks * 256) * 6144 + j0 + col;
#pragma unroll 16
            for (int k = 0; k < 256; ++k) {
                const float w = wp[(size_t)k * 6144];
                const LAS f32x4* cl = (const LAS f32x4*)(condL + (ks * 256 + k) * 32);
#pragma unroll
                for (int q = 0; q < 8; ++q) { const f32x4 cv = cl[q]; acc[4 * q] += w * cv.x; acc[4 * q + 1] += w * cv.y; acc[4 * q + 2] += w * cv.z; acc[4 * q + 3] += w * cv.w; }
            }
            const float bias = b_ada[l * 6144 + j0 + col];
#pragma unroll
            for (int b = 0; b < 32; ++b) { float v = acc[b]; v += __shfl_xor(v, 16); v += __shfl_xor(v, 32); if (ks == 0) MOD[((size_t)l * NB + b) * 6144 + j0 + col] = v + bias; }
        }
        __syncthreads();
    }
    {
        LAS float* scr = (LAS float*)(F.lds + F.wave * 16384);
        const int gw = F.bx * NWAVES + F.wave, NGW = F.G * NWAVES;
        bf16* WinT = (bf16*)(ws + WS_WIN); bf16* WmlaT = (bf16*)(ws + WS_WMLA); bf16* WbrT = (bf16*)(ws + WS_WBR); bf16* WoutT = (bf16*)(ws + WS_WOUT);
        bf16* WguT = (bf16*)(ws + WS_WGU); bf16* WdT = (bf16*)(ws + WS_WD);
        for (int it = gw; it < NL * NITEM_L; it += NGW) {
            const int l = it / NITEM_L; int r = it % NITEM_L;
            if (r < I_IN) { const int kb = r / 214, nb = r % 214; tr_item(inp(F, 7) + (size_t)l * D * IN_COLS, IN_COLS, WinT + (size_t)l * NP * 1024, 1024, 0, scr, 64 * kb, 32 * nb, F.lane, MapIn{}); continue; } r -= I_IN;
            if (r < I_UQ) { const int kb = r / 12, nb = r % 12; tr_item(inp(F, 13) + (size_t)l * 256 * 384, 384, WmlaT + (size_t)l * 1024 * 384, 384, 0, scr, 64 * kb, 32 * nb, F.lane, MapIdent{0}); continue; } r -= I_UQ;
            if (r < I_UKV) { const int kb = r / 16, nb = r % 16; tr_item(inp(F, 14) + (size_t)l * 128 * 512, 512, WmlaT + (size_t)l * 1024 * 384, 384, 256, scr, 64 * kb, 32 * nb, F.lane, MapIdent{384}); continue; } r -= I_UKV;
            if (r < I_BR) { const int b = r / 128, rr = r % 128, kb = rr / 32, nb = rr % 32; tr_item(inp(F, 20) + (size_t)(l * 4 + b) * 256 * 1024, 1024, WbrT + (size_t)(l * 4 + b) * 1024 * 256, 256, 0, scr, 64 * kb, 32 * nb, F.lane, MapIdent{0}); continue; } r -= I_BR;
            if (r < I_OUT) { const int kb = r / 32, nb = r % 32; tr_item(inp(F, 21) + (size_t)l * 1024 * 1024, 1024, WoutT + (size_t)l * 1024 * 1024, 1024, 0, scr, 64 * kb, 32 * nb, F.lane, MapIdent{0}); continue; } r -= I_OUT;
            if (r < I_G) { const int e = r / 128, rr = r % 128, kb = rr / 8, nb = rr % 8; const float* src = e < 16 ? inp(F, 24) + (size_t)(l * 16 + e) * 1024 * 256 : inp(F, 27) + (size_t)l * 1024 * 256;
                tr_item(src, 256, WguT + (size_t)(l * NEXP1 + e) * 512 * 1024, 1024, 0, scr, 64 * kb, 32 * nb, F.lane, MapGate{0}); continue; } r -= I_G;
            if (r < I_G) { const int e = r / 128, rr = r % 128, kb = rr / 8, nb = rr % 8; const float* src = e < 16 ? inp(F, 25) + (size_t)(l * 16 + e) * 1024 * 256 : inp(F, 28) + (size_t)l * 1024 * 256;
                tr_item(src, 256, WguT + (size_t)(l * NEXP1 + e) * 512 * 1024, 1024, 0, scr, 64 * kb, 32 * nb, F.lane, MapGate{128}); continue; } r -= I_G;
            if (r >= I_DN) { r -= I_DN; const int kb = r / 128, nb = r % 128;
                tr_item8(inp(F, 7) + (size_t)l * D * IN_COLS, IN_COLS, (unsigned char*)(WinT + ((size_t)l * NP + PG) * 1024), 1024, scr, 64 * kb, 2724 + 32 * nb, 2724, F.lane, WG8_SCALE); continue; }
            { const int e = r / 128, rr = r % 128, kb = rr / 32, nb = rr % 32; const float* src = e < 16 ? inp(F, 26) + (size_t)(l * 16 + e) * 256 * 1024 : inp(F, 29) + (size_t)l * 256 * 1024;
                tr_item(src, 1024, WdT + (size_t)(l * NEXP1 + e) * 1024 * 256, 256, 0, scr, 64 * kb, 32 * nb, F.lane, MapIdent{0}); }
        }
        const int gt = F.bx * NTHREADS + F.tid, NGT = F.G * NTHREADS;
        const v4u z = {0u, 0u, 0u, 0u};
        for (int p = gt; p < NL * 92 * 128; p += NGT) { const int l = p / (92 * 128), q = p % (92 * 128), row = 2724 + q / 128, kc = (q % 128) * 8; *(v4u*)(WinT + ((size_t)l * NP + row) * 1024 + kc) = z; }
        for (int p = gt; p < NL * 1024 * 48; p += NGT) { const int l = p / (1024 * 48), q = p % (1024 * 48), row = q / 48, kc = (q % 48) * 8;
            const bool zr = (row < 384 && kc >= 256) || (row >= 384 && row < 896 && kc < 256) || row >= 896;
            if (zr) *(v4u*)(WmlaT + ((size_t)l * 1024 + row) * 384 + kc) = z; }
    }
}

template <bool ROUTER>
DI void norm_phase(const Frame& F, const Args& A, const float* xs, const bf16* xb, int chunk, int layer) {
    unsigned char* ws = F.ws;
    bf16* H = (bf16*)(ws + WS_H);
    const float* gain = inp(F, ROUTER ? 4 : 3) + layer * D;
    const float* MOD = (const float*)(ws + WS_MOD) + (size_t)layer * NB * 6144;
    const int SH = ROUTER ? 3072 : 0, SC = ROUTER ? 4096 : 1024;
    LAS f32x4* RW = (LAS f32x4*)F.lds;
    LAS float* wscr = (LAS float*)(F.lds + 65536) + F.wave * 64;
    LAS int* cntL = (LAS int*)(F.lds + 65536 + 2048);
    LAS int* baseL = cntL + 16; LAS int* selL = cntL + 64;
    if (ROUTER) {
        const float* rw = inp(F, 22);
        for (int idx = F.tid; idx < 4 * 16 * 64; idx += NTHREADS) { const int ln = idx & 63, e = (idx >> 6) & 15, j = idx >> 10; const int col = 4 * ln + 256 * j;
            RW[idx] = (f32x4){rw[(col + 0) * 16 + e], rw[(col + 1) * 16 + e], rw[(col + 2) * 16 + e], rw[(col + 3) * 16 + e]}; }
        if (F.tid < 16) cntL[F.tid] = 0;
        __syncthreads();
    }
    for (int rb = F.bx; rb < TC / 128; rb += F.G) {
        const int r0 = rb * 128 + F.wave * 16;
        const int b = (chunk * TC + r0) / S;
        f32x4 gs[4], shv[4];
#pragma unroll
        for (int j = 0; j < 4; ++j) { const int col = 4 * F.lane + 256 * j; const f32x4 g = *(const f32x4*)(gain + col), sc = *(const f32x4*)(MOD + (size_t)b * 6144 + SC + col);
            gs[j] = g * (sc + 1.0f); shv[j] = *(const f32x4*)(MOD + (size_t)b * 6144 + SH + col); }
        for (int rq = 0; rq < 16; rq += 4) {
            f32x4 y[4][4];
#pragma unroll
            for (int rr = 0; rr < 4; ++rr) {
                const int row = r0 + rq + rr;
                float ss = 0.f;
                if (xs) { const f32x4* xr = (const f32x4*)(xs + (size_t)row * D) + F.lane;
#pragma unroll
                    for (int j = 0; j < 4; ++j) y[rr][j] = xr[64 * j]; }
                else { const v2u* xr = (const v2u*)(xb + (size_t)row * D) + F.lane;
#pragma unroll
                    for (int j = 0; j < 4; ++j) { const v2u r = xr[64 * j]; y[rr][j] = (f32x4){bf_lo(r.x), bf_hi(r.x), bf_lo(r.y), bf_hi(r.y)}; } }
#pragma unroll
                for (int j = 0; j < 4; ++j) { ss += (y[rr][j].x * y[rr][j].x + y[rr][j].y * y[rr][j].y) + (y[rr][j].z * y[rr][j].z + y[rr][j].w * y[rr][j].w); }
                const float rs = 1.0f / sqrtf(wave_sum(ss) * (1.0f / D) + EPS);
                unsigned long long* o8 = (unsigned long long*)(H + (size_t)row * D) + F.lane;
#pragma unroll
                for (int j = 0; j < 4; ++j) { y[rr][j] = y[rr][j] * rs * gs[j] + shv[j];
                    o8[64 * j] = (unsigned long long)cvt_pk_bf16(y[rr][j].x, y[rr][j].y) | ((unsigned long long)cvt_pk_bf16(y[rr][j].z, y[rr][j].w) << 32);
                    if (!ROUTER) { const f32x4 c = __builtin_elementwise_min(__builtin_elementwise_max(y[rr][j], (f32x4){-448.f, -448.f, -448.f, -448.f}), (f32x4){448.f, 448.f, 448.f, 448.f});
                        *(unsigned*)(ws + WS_H8 + (size_t)row * D + 4 * F.lane + 256 * j) = pk4_fp8(c.x, c.y, c.z, c.w); } }
            }
            if (ROUTER) {
                float v[64];
#pragma unroll
                for (int i = 0; i < 64; ++i) v[i] = 0.f;
#pragma unroll
                for (int j = 0; j < 4; ++j)
#pragma unroll
                    for (int e = 0; e < 16; ++e) { const f32x4 w = RW[(j * 16 + e) * 64 + F.lane];
#pragma unroll
                        for (int rr = 0; rr < 4; ++rr) v[rr * 16 + e] += (y[rr][j].x * w.x + y[rr][j].y * w.y) + (y[rr][j].z * w.z + y[rr][j].w * w.w); }
#pragma unroll
                for (int d = 32; d >= 1; d >>= 1) {
                    const bool up = (F.lane & d) != 0;
#pragma unroll
                    for (int k = 0; k < d; ++k) { const float send = up ? v[k] : v[k + d]; const float keep = up ? v[k + d] : v[k]; v[k] = keep + __shfl_xor(send, d); }
                }
                wscr[F.lane] = v[0];
                __builtin_amdgcn_wave_barrier();
                asm volatile("s_waitcnt lgkmcnt(0)" ::: "memory");
                float lg[16];
                { const LAS f32x4* p = (const LAS f32x4*)(wscr + (F.lane >> 4) * 16);
#pragma unroll
                  for (int q = 0; q < 4; ++q) { const f32x4 t = p[q]; lg[4 * q] = t.x; lg[4 * q + 1] = t.y; lg[4 * q + 2] = t.z; lg[4 * q + 3] = t.w; } }
                __builtin_amdgcn_wave_barrier();
                const float* rbias = inp(F, 23);
                float sc[16], sel[16];
#pragma unroll
                for (int e = 0; e < 16; ++e) { sc[e] = 1.0f / (1.0f + expf(-lg[e])); sel[e] = sc[e] + rbias[e]; }
                float gsc[4];
#pragma unroll
                for (int g = 0; g < 4; ++g) { const float a0 = sel[4 * g], a1 = sel[4 * g + 1], a2 = sel[4 * g + 2], a3 = sel[4 * g + 3];
                    const float h1 = fmaxf(a0, a1), l1 = fminf(a0, a1), h2 = fmaxf(a2, a3), l2 = fminf(a2, a3);
                    gsc[g] = fmaxf(h1, h2) + fmaxf(fminf(h1, h2), fmaxf(l1, l2)); }
                int grp = 0; float best = gsc[0];
#pragma unroll
                for (int g = 1; g < 4; ++g) if (gsc[g] > best) { best = gsc[g]; grp = g; }
                float a[4], s4[4];
#pragma unroll
                for (int k = 0; k < 4; ++k) { a[k] = sel[k]; s4[k] = sc[k]; }
#pragma unroll
                for (int g = 1; g < 4; ++g) if (grp == g) {
#pragma unroll
                    for (int k = 0; k < 4; ++k) { a[k] = sel[4 * g + k]; s4[k] = sc[4 * g + k]; } }
                int i1 = 0; float m1 = a[0];
#pragma unroll
                for (int k = 1; k < 4; ++k) if (a[k] > m1) { m1 = a[k]; i1 = k; }
                int i2 = -1; float m2 = -3.0e38f;
#pragma unroll
                for (int k = 0; k < 4; ++k) if (k != i1 && a[k] > m2) { m2 = a[k]; i2 = k; }
                float w1 = s4[0], w2 = s4[0];
#pragma unroll
                for (int k = 1; k < 4; ++k) { if (i1 == k) w1 = s4[k]; if (i2 == k) w2 = s4[k]; }
                const float inv = 1.0f / (w1 + w2);
                if ((F.lane & 15) == 0) {
                    const int tl = F.wave * 16 + rq + (F.lane >> 4);
                    const int e1 = grp * 4 + i1, e2 = grp * 4 + i2;
                    float* tw = (float*)(ws + WS_TOKW); const int row = rb * 128 + tl;
                    tw[row * 2] = w1 * inv; tw[row * 2 + 1] = w2 * inv;
                    const int k1 = __hip_atomic_fetch_add(cntL + e1, 1, __ATOMIC_RELAXED, __HIP_MEMORY_SCOPE_WORKGROUP), k2 = __hip_atomic_fetch_add(cntL + e2, 1, __ATOMIC_RELAXED, __HIP_MEMORY_SCOPE_WORKGROUP);
                    selL[tl * 2] = (e1 << 20) | k1; selL[tl * 2 + 1] = (e2 << 20) | k2;
                }
            }
        }
        if (ROUTER) {
            __syncthreads();
            if (F.tid < 16) { baseL[F.tid] = (int)__hip_atomic_fetch_add((unsigned*)(ws + WS_CTL) + CW_GCNT + 64 * (chunk * NL + layer) + F.tid, (unsigned)cntL[F.tid], __ATOMIC_RELAXED, __HIP_MEMORY_SCOPE_AGENT); }
            __syncthreads();
            if (F.tid < 256) { const int sv = selL[F.tid], e = sv >> 20, lp = baseL[e] + (sv & 0xfffff);
                ((int*)(ws + WS_LIST))[e * TC + lp] = rb * 128 + (F.tid >> 1); ((int*)(ws + WS_TOKPOS))[(rb * 128) * 2 + F.tid] = (e << 20) | lp; }
            __syncthreads();
            if (F.tid < 16) cntL[F.tid] = 0;
            __syncthreads();
        }
    }
}

DI float sum16(float v) { v += __shfl_xor(v, 1); v += __shfl_xor(v, 2); v += __shfl_xor(v, 4); v += __shfl_xor(v, 8); return v; }

DI void head_norm4(bf16* p, const f32x4 g, int lane) {
    const v2u raw = *(const v2u*)(p + 4 * lane);
    f32x4 f = {bf_lo(raw.x), bf_hi(raw.x), bf_lo(raw.y), bf_hi(raw.y)};
    const float ss = sum16((f.x * f.x + f.y * f.y) + (f.z * f.z + f.w * f.w));
    const float rs = 1.0f / sqrtf(ss * (1.0f / 64.0f) + EPS);
    f = f * rs * g;
    v2u o; o.x = cvt_pk_bf16(f.x, f.y); o.y = cvt_pk_bf16(f.z, f.w);
    *(v2u*)(p + 4 * lane) = o;
}

DI void prep1_phase(const Frame& F, const Args& A, int chunk, int layer) {
    unsigned char* ws = F.ws;
    bf16* PROJ = (bf16*)(ws + WS_PROJ);
    float* LOGF = (float*)(ws + WS_LOGF); float* ROPE = (float*)(ws + WS_ROPE);
    const int* positions = (const int*)inp(F, 2);
    const int lane = F.lane, d4 = (4 * lane) & 63;
    f32x4 gh[4];
    gh[0] = *(const f32x4*)(inp(F, 9) + layer * 64 + d4); gh[1] = *(const f32x4*)(inp(F, 10) + layer * 64 + d4);
    gh[2] = *(const f32x4*)(inp(F, 17) + layer * 64 + d4); gh[3] = *(const f32x4*)(inp(F, 18) + layer * 64 + d4);
    const f32x4 g_lq = *(const f32x4*)(inp(F, 11) + layer * 256 + 4 * lane);
    const f32x2 g_lkv = *(const f32x2*)(inp(F, 12) + layer * 128 + 2 * lane);
    const float fb = inp(F, 8)[layer * 4 + (lane & 3)];
    const float invf = exp2f(-(float)(lane & 15) * (13.287712379549449f / 16.0f));
    const int gw = F.bx * NWAVES + F.wave, NGW = F.G * NWAVES;
    constexpr int HOFF[4] = {PA_Q, PA_K, PD_Q, PD_K};
    for (int r0 = gw * 16; r0 < TC; r0 += NGW * 16) {
        for (int rq = 0; rq < 16; rq += 4) {
            v2u rh[4][4], rc[4]; unsigned rkv[4];
#pragma unroll
            for (int rr = 0; rr < 4; ++rr) { const bf16* pr = PROJ + (size_t)(r0 + rq + rr) * PS;
#pragma unroll
                for (int k = 0; k < 4; ++k) rh[rr][k] = *(const v2u*)(pr + HOFF[k] + 4 * lane);
                rc[rr] = *(const v2u*)(pr + PC_CQ + 4 * lane); rkv[rr] = *(const unsigned*)(pr + PC_CKV + 2 * lane); }
            const int rowl = r0 + rq + (lane >> 4), il = lane & 15; bf16* prl = PROJ + (size_t)rowl * PS;
            const float t1 = bf2f(prl[PC_KR + il]), t2 = bf2f(prl[PC_KR + 16 + il]);
            const float pos = (float)positions[(size_t)chunk * TC + rowl];
            const int rowf = r0 + rq + ((lane >> 2) & 3);
            const float fav = bf2f(PROJ[(size_t)rowf * PS + PC_FA + (lane & 3)]);
#pragma unroll
            for (int rr = 0; rr < 4; ++rr) { bf16* pr = PROJ + (size_t)(r0 + rq + rr) * PS;
                f32x4 f[4]; float ss[4];
#pragma unroll
                for (int k = 0; k < 4; ++k) { f[k] = (f32x4){bf_lo(rh[rr][k].x), bf_hi(rh[rr][k].x), bf_lo(rh[rr][k].y), bf_hi(rh[rr][k].y)}; ss[k] = (f[k].x * f[k].x + f[k].y * f[k].y) + (f[k].z * f[k].z + f[k].w * f[k].w); }
#pragma unroll
                for (int o = 1; o < 16; o <<= 1) {
#pragma unroll
                    for (int k = 0; k < 4; ++k) ss[k] += __shfl_xor(ss[k], o); }
#pragma unroll
                for (int k = 0; k < 4; ++k) { const float rs = 1.0f / sqrtf(ss[k] * (1.0f / 64.0f) + EPS); f[k] = f[k] * rs * gh[k];
                    v2u o; o.x = cvt_pk_bf16(f[k].x, f[k].y); o.y = cvt_pk_bf16(f[k].z, f[k].w); *(v2u*)(pr + HOFF[k] + 4 * lane) = o; }
            }
            {
                f32x4 fq[4]; float a[4], b[4], s1[4], s2[4];
#pragma unroll
                for (int rr = 0; rr < 4; ++rr) { fq[rr] = (f32x4){bf_lo(rc[rr].x), bf_hi(rc[rr].x), bf_lo(rc[rr].y), bf_hi(rc[rr].y)}; a[rr] = bf_lo(rkv[rr]); b[rr] = bf_hi(rkv[rr]);
                    s1[rr] = (fq[rr].x * fq[rr].x + fq[rr].y * fq[rr].y) + (fq[rr].z * fq[rr].z + fq[rr].w * fq[rr].w); s2[rr] = a[rr] * a[rr] + b[rr] * b[rr]; }
#pragma unroll
                for (int o = 1; o < 64; o <<= 1) {
#pragma unroll
                    for (int rr = 0; rr < 4; ++rr) { s1[rr] += __shfl_xor(s1[rr], o); s2[rr] += __shfl_xor(s2[rr], o); } }
#pragma unroll
                for (int rr = 0; rr < 4; ++rr) { bf16* pr = PROJ + (size_t)(r0 + rq + rr) * PS;
                    const float r1 = 1.0f / sqrtf(s1[rr] * (1.0f / 256.0f) + EPS), r2 = 1.0f / sqrtf(s2[rr] * (1.0f / 128.0f) + EPS);
                    const f32x4 q = fq[rr] * r1 * g_lq; v2u o; o.x = cvt_pk_bf16(q.x, q.y); o.y = cvt_pk_bf16(q.z, q.w);
                    *(v2u*)(pr + PC_CQ + 4 * lane) = o; *(unsigned*)(pr + PC_CKV + 2 * lane) = cvt_pk_bf16(a[rr] * r2 * g_lkv.x, b[rr] * r2 * g_lkv.y); }
            }
            {
                const float ang = pos * invf;
                float sn, cs; sincosf(ang, &sn, &cs);
                const unsigned o = cvt_pk_bf16(t1 * cs - t2 * sn, t1 * sn + t2 * cs);
                prl[PC_KR + il] = (bf16)(o & 0xffffu); prl[PC_KR + 16 + il] = (bf16)(o >> 16);
                ROPE[(size_t)rowl * 32 + il] = cs; ROPE[(size_t)rowl * 32 + 16 + il] = sn;
            }
            if (lane < 16) {
                const float v = fav + fb;
                LOGF[(size_t)rowf * 4 + (lane & 3)] = (v > 0.f) ? -log1pf(expf(-v)) : v - log1pf(expf(v));
            }
        }
    }
}

constexpr float QSCALE_C = 0.10206207261596577f * LOG2E;
DI void prep2_phase(const Frame& F, const Args& A, int layer) {
    unsigned char* ws = F.ws;
    const bf16* PROJ = (const bf16*)(ws + WS_PROJ); const bf16* QKVC = (const bf16*)(ws + WS_QKVC); const float* ROPE = (const float*)(ws + WS_ROPE);
    bf16* QC = (bf16*)(ws + WS_QC); bf16* KC = (bf16*)(ws + WS_KC);
    const int lane = F.lane, hh = lane >> 4, jj = lane & 15;
    LAS float* sq = (LAS float*)(F.lds + F.wave * 8192);
    LAS float* sk = sq + 384;
    LAS bf16* sb = (LAS bf16*)(sq + 768);
    float gq[6], gk[6];
#pragma unroll
    for (int k = 0; k < 6; ++k) { gq[k] = inp(F, 15)[layer * 96 + jj + 16 * k] * QSCALE_C; gk[k] = inp(F, 16)[layer * 96 + jj + 16 * k]; }
    const int gw = F.bx * NWAVES + F.wave, NGW = F.G * NWAVES;
    for (int r0 = gw * 16; r0 < TC; r0 += NGW * 16) {
        for (int rr = 0; rr < 16; ++rr) {
            const int row = r0 + rr;
            const bf16* qrow = QKVC + (size_t)row * 1024;
            if (lane < 48) { const v4u raw = *(const v4u*)(qrow + 8 * lane); LAS float* d = sq + 8 * lane;
                d[0] = bf_lo(raw.x); d[1] = bf_hi(raw.x); d[2] = bf_lo(raw.y); d[3] = bf_hi(raw.y); d[4] = bf_lo(raw.z); d[5] = bf_hi(raw.z); d[6] = bf_lo(raw.w); d[7] = bf_hi(raw.w); }
            { const int o = 8 * jj;
              if (o < 64) { const v4u raw = *(const v4u*)(qrow + 384 + 128 * hh + o); LAS float* d = sk + 96 * hh + o;
                d[0] = bf_lo(raw.x); d[1] = bf_hi(raw.x); d[2] = bf_lo(raw.y); d[3] = bf_hi(raw.y); d[4] = bf_lo(raw.z); d[5] = bf_hi(raw.z); d[6] = bf_lo(raw.w); d[7] = bf_hi(raw.w); } }
            if (lane < 4) { const v4u raw = *(const v4u*)(PROJ + (size_t)row * PS + PC_KR + 8 * lane);
                const float f[8] = {bf_lo(raw.x), bf_hi(raw.x), bf_lo(raw.y), bf_hi(raw.y), bf_lo(raw.z), bf_hi(raw.z), bf_lo(raw.w), bf_hi(raw.w)};
#pragma unroll
                for (int h = 0; h < 4; ++h)
#pragma unroll
                    for (int i = 0; i < 8; ++i) sk[96 * h + 64 + 8 * lane + i] = f[i]; }
            const float cs = ROPE[(size_t)row * 32 + jj], sn = ROPE[(size_t)row * 32 + 16 + jj];
            __builtin_amdgcn_wave_barrier(); asm volatile("s_waitcnt lgkmcnt(0)" ::: "memory");
            { const float t1 = sq[96 * hh + 64 + jj], t2 = sq[96 * hh + 80 + jj];
              __builtin_amdgcn_wave_barrier();
              sq[96 * hh + 64 + jj] = t1 * cs - t2 * sn; sq[96 * hh + 80 + jj] = t1 * sn + t2 * cs; }
            __builtin_amdgcn_wave_barrier(); asm volatile("s_waitcnt lgkmcnt(0)" ::: "memory");
            float qv[6], kv[6], sq2 = 0.f, sk2 = 0.f;
#pragma unroll
            for (int k = 0; k < 6; ++k) { qv[k] = sq[96 * hh + jj + 16 * k]; kv[k] = sk[96 * hh + jj + 16 * k]; sq2 += qv[k] * qv[k]; sk2 += kv[k] * kv[k]; }
            const float rq = 1.0f / sqrtf(sum16(sq2) * (1.0f / 96.0f) + EPS), rk = 1.0f / sqrtf(sum16(sk2) * (1.0f / 96.0f) + EPS);
            __builtin_amdgcn_wave_barrier();
#pragma unroll
            for (int k = 0; k < 6; ++k) { const unsigned o = cvt_pk_bf16(qv[k] * rq * gq[k], kv[k] * rk * gk[k]);
                sb[96 * hh + jj + 16 * k] = (bf16)(o & 0xffffu); sb[384 + 96 * hh + jj + 16 * k] = (bf16)(o >> 16); }
            __builtin_amdgcn_wave_barrier(); asm volatile("s_waitcnt lgkmcnt(0)" ::: "memory");
            if (lane < 48) { *(v4u*)(QC + (size_t)row * 384 + 8 * lane) = *(const LAS v4u*)(sb + 8 * lane); *(v4u*)(KC + (size_t)row * 384 + 8 * lane) = *(const LAS v4u*)(sb + 384 + 8 * lane); }
            __builtin_amdgcn_wave_barrier(); asm volatile("s_waitcnt lgkmcnt(0)" ::: "memory");
        }
    }
}

DI void route_phase(const Frame& F) {
    unsigned char* ws = F.ws;
    const int* CNT = (const int*)(ws + WS_CNT); const int* TOKE = (const int*)(ws + WS_TOKE); int* TOKPOS = (int*)(ws + WS_TOKPOS);
    int* TILEEXP = (int*)(ws + WS_TILEEXP);
    const bf16* H = (const bf16*)(ws + WS_H); bf16* HS = (bf16*)(ws + WS_HS);
    LAS int* cntL = (LAS int*)F.lds;
    LAS int* totL = cntL + 4096;
    LAS int* preL = totL + 16;
    LAS int* baseL = preL + 16;
    LAS int* wc0L = baseL + 16;
    LAS int* posL = wc0L + 16;
    constexpr int NRB = TC / 128;
    for (int idx = F.tid; idx < NRB * 16; idx += NTHREADS) cntL[idx] = CNT[idx];
    __syncthreads();
    for (int rb = F.bx; rb < NRB; rb += F.G) {
        if (F.tid < 16) { int tot = 0, pre = 0; for (int t = 0; t < NRB; ++t) { const int c = cntL[t * 16 + F.tid]; if (t < rb) pre += c; tot += c; } totL[F.tid] = tot; preL[F.tid] = pre; }
        __syncthreads();
        if (F.tid == 0) { int base = 0; for (int e = 0; e < 16; ++e) { baseL[e] = base; base += ((totL[e] + 255) >> 8) << 8; }
            if (rb == 0) { int m = 0; for (int e = 0; e < 16; ++e) { const int nt = (totL[e] + 255) >> 8; for (int j = 0; j < nt; ++j) TILEEXP[m++] = e; } TILEEXP[NMT_WORD] = m; } }
        __syncthreads();
        if (F.tid < 128) {
            const int t = rb * 128 + F.tid; const int e0 = TOKE[t * 2], e1 = TOKE[t * 2 + 1];
            int rk0 = 0, rk1 = 0;
            const unsigned long long lt = (1ull << F.lane) - 1ull;
            for (int e = 0; e < 16; ++e) {
                const unsigned long long m = __ballot(e0 == e || e1 == e);
                const int r = __popcll(m & lt);
                if (e0 == e) rk0 = r; if (e1 == e) rk1 = r;
                if (F.wave == 0 && F.lane == 0) wc0L[e] = __popcll(m);
            }
            asm volatile("s_waitcnt lgkmcnt(0)" ::: "memory");
            posL[256 + F.tid * 2] = rk0; posL[256 + F.tid * 2 + 1] = rk1;
        }
        __syncthreads();
        if (F.tid < 128) {
            const int t = rb * 128 + F.tid; const int e0 = TOKE[t * 2], e1 = TOKE[t * 2 + 1];
            const int add0 = (F.wave == 1) ? wc0L[e0] : 0, add1 = (F.wave == 1) ? wc0L[e1] : 0;
            const int p0 = baseL[e0] + preL[e0] + posL[256 + F.tid * 2] + add0, p1 = baseL[e1] + preL[e1] + posL[256 + F.tid * 2 + 1] + add1;
            TOKPOS[t * 2] = p0; TOKPOS[t * 2 + 1] = p1; posL[F.tid * 2] = p0; posL[F.tid * 2 + 1] = p1;
        }
        __syncthreads();
        for (int it = F.wave * 32; it < F.wave * 32 + 32; ++it) {
            const int tl = it >> 1; const int pos = posL[it];
            const v4u* src = (const v4u*)(H + (size_t)(rb * 128 + tl) * 1024); v4u* dst = (v4u*)(HS + (size_t)pos * 1024);
            const v4u a = src[F.lane], b = src[64 + F.lane]; dst[F.lane] = a; dst[64 + F.lane] = b;
        }
        __syncthreads();
    }
}

namespace att {
constexpr int KBYTES = 12288, VBYTES = 8192;
constexpr int NSLOT = 3, L_K = 0, L_V = NSLOT * KBYTES, L_WSF = NSLOT * (KBYTES + VBYTES), L_BIAS = L_WSF + 1024, L_REL = L_BIAS + 8192, L_SCAN = L_REL + 1056, L_DONE = L_SCAN + 64, L_OST = L_DONE + 64, L_END = L_OST + 8 * 4096;
static_assert(L_END <= RING_BYTES, "attention LDS");
DI int crow(int r, int hi) { return (r & 3) + 8 * (r >> 2) + 4 * hi; }
#define MFMA32(a, b, c) __builtin_amdgcn_mfma_f32_32x32x16_bf16((a), (b), (c), 0, 0, 0)
typedef short v4i16_t __attribute__((ext_vector_type(4)));
DI s16x4 vtr(const LAS unsigned char* p) { return __builtin_bit_cast(s16x4, __builtin_amdgcn_ds_read_tr16_b64_v4i16((LAS v4i16_t*)p)); }
DI float max3f(float a, float b, float c) { return __builtin_fmaxf(__builtin_fmaxf(a, b), c); }
DI float swap_max(float m) { auto rr = __builtin_amdgcn_permlane32_swap(__float_as_uint(m), __float_as_uint(m), false, false); return fmaxf(__uint_as_float(rr[0]), __uint_as_float(rr[1])); }
DI float swap_sum(float m) { auto rr = __builtin_amdgcn_permlane32_swap(__float_as_uint(m), __float_as_uint(m), false, false); return __uint_as_float(rr[0]) + __uint_as_float(rr[1]); }

struct Tens { const bf16* Q; const bf16* K; const bf16* V; int pq, pk, pv; bf16* O; float qscale; };

template <int MIX>
DI void attn_unit(const Frame& F, const Tens& T, int b, int h, int qb, const float* logf, const float* relb) {
    constexpr int DQK = (MIX == 2) ? 96 : 64, NKS = DQK / 16;
    LAS unsigned char* lds = F.lds;
    const int tid = F.tid, lane = F.lane, wid = F.wave, r32 = lane & 31, hi = lane >> 5;
    const int rowbase = b * S, q0 = qb * 256, q0w = q0 + 32 * wid, cw = q0w >> 6;
    LAS float* wsf = (LAS float*)(lds + L_WSF) + wid * 32;
    LAS float* biasL = (LAS float*)(lds + L_BIAS);
    LAS float* relL = (LAS float*)(lds + L_REL);
    __syncthreads();
    const int t_hi = 4 * qb + 3;
    const int t_lo = (MIX == 3) ? ((4 * qb - 8) > 0 ? (4 * qb - 8) : 0) : 0;
    const int ntile = t_hi - t_lo + 1;
    const char* Kb = (const char*)(T.K + (size_t)rowbase * T.pk); const char* Vb = (const char*)(T.V + (size_t)rowbase * T.pv);
    const unsigned koff0 = (unsigned)(((tid & 63) * T.pk + 8 * (tid >> 6)) * 2);
    const unsigned voff = (unsigned)(((16 * (wid & 3) + (lane >> 2)) * T.pv + (wid >> 2) * 32 + (lane & 3) * 8) * 2);
    const bool k2 = (DQK == 96) && (wid < 4);
#define ATT_ISSUE(t, slot) do { const char* kt = Kb + (size_t)(t) * 128 * T.pk; const char* vt = Vb + (size_t)(t) * 128 * T.pv; \
        __builtin_amdgcn_global_load_lds((const unsigned*)(kt + koff0), (LAS unsigned*)(lds + L_K + (slot) * KBYTES + wid * 1024), 16, 0, 0); \
        if (k2) __builtin_amdgcn_global_load_lds((const unsigned*)(kt + koff0 + 128), (LAS unsigned*)(lds + L_K + (slot) * KBYTES + 8192 + wid * 1024), 16, 0, 0); \
        __builtin_amdgcn_global_load_lds((const unsigned*)(vt + voff), (LAS unsigned*)(lds + L_V + (slot) * VBYTES + wid * 1024), 16, 0, 0); } while (0)
#define ATT_WAITBAR(n) asm volatile("s_waitcnt vmcnt(" #n ") lgkmcnt(0)\n\ts_barrier" ::: "memory")
#define ATT_WAIT_NEWEST() do { if (k2) ATT_WAITBAR(3); else ATT_WAITBAR(2); } while (0)
#define ATT_TILE(it) ((MIX == 1) ? (t_hi - (it)) : (t_lo + (it)))
    ATT_ISSUE(ATT_TILE(0), 0);
    if (ntile > 1) ATT_ISSUE(ATT_TILE(1), 1);
    if (MIX == 0) {
        LAS float* scanL = (LAS float*)(lds + L_SCAN);
        float lf[4]; float run = 0.f;
#pragma unroll
        for (int i = 0; i < 4; ++i) { run += logf[(size_t)(rowbase + 4 * tid + i) * 4 + h]; lf[i] = run; }
        float inc = run;
#pragma unroll
        for (int o = 1; o < 64; o <<= 1) { const float t = __shfl_up(inc, o); if (lane >= o) inc += t; }
        if (lane == 63) scanL[wid] = inc;
        asm volatile("s_waitcnt lgkmcnt(0)\n\ts_barrier" ::: "memory");
        float off = inc - run;
        for (int w = 0; w < wid; ++w) off += scanL[w];
#pragma unroll
        for (int i = 0; i < 4; ++i) biasL[4 * tid + i] = -LOG2E * (off + lf[i]);
    }
    if (MIX == 3) { const float far = relb[256]; for (int i = tid; i < 257; i += NTHREADS) relL[i] = (relb[i] - far) * LOG2E; }
    bf16x8 qr[NKS];
    {
        const char* qb_ = (const char*)(T.Q + (size_t)(rowbase + q0w) * T.pq); const unsigned qoff = (unsigned)((r32 * T.pq + 8 * hi) * 2);
#pragma unroll
        for (int d0 = 0; d0 < NKS; ++d0) { const v4u raw = *(const v4u*)(qb_ + qoff + 32 * d0); v4u s;
            s.x = cvt_pk_bf16(bf_lo(raw.x) * T.qscale, bf_hi(raw.x) * T.qscale); s.y = cvt_pk_bf16(bf_lo(raw.y) * T.qscale, bf_hi(raw.y) * T.qscale);
            s.z = cvt_pk_bf16(bf_lo(raw.z) * T.qscale, bf_hi(raw.z) * T.qscale); s.w = cvt_pk_bf16(bf_lo(raw.w) * T.qscale, bf_hi(raw.w) * T.qscale);
            qr[d0] = __builtin_bit_cast(bf16x8, s); }
    }
    f32x16 o0, o1;
#pragma unroll
    for (int i = 0; i < 16; ++i) { o0[i] = 0.f; o1[i] = 0.f; }
    float mrun = -1.0e30f, lrun = 0.f, arun = 0.f;
    bool bdone = false;
    LAS int* doneL = (LAS int*)(lds + L_DONE);
    ATT_WAITBAR(0);
    int slot = 0;
    for (int it = 0; it < ntile; ++it) {
        const int t = ATT_TILE(it);
        const bool more = (it + 2 < ntile);
        if (more) { const int s2 = (slot == 0) ? 2 : slot - 1; ATT_ISSUE(ATT_TILE(it + 2), s2); }
        const bool part = (MIX == 3) ? (t <= cw && t >= cw - 8) : ((MIX == 1) ? (t <= cw && !bdone) : (t <= cw));
        if (part) {
            const LAS unsigned char* kb = lds + L_K + slot * KBYTES + hi * 1024 + r32 * 16;
            f32x16 p0, p1;
            if (MIX == 0) {
                const LAS f32x4* bp = (const LAS f32x4*)(biasL + 64 * t + 4 * hi);
#pragma unroll
                for (int g = 0; g < 4; ++g) { const f32x4 b0 = bp[2 * g], b1 = bp[8 + 2 * g];
                    p0[4 * g] = b0.x; p0[4 * g + 1] = b0.y; p0[4 * g + 2] = b0.z; p0[4 * g + 3] = b0.w; p1[4 * g] = b1.x; p1[4 * g + 1] = b1.y; p1[4 * g + 2] = b1.z; p1[4 * g + 3] = b1.w; }
            } else {
#pragma unroll
                for (int i = 0; i < 16; ++i) { p0[i] = 0.f; p1[i] = 0.f; }
            }
#pragma unroll
            for (int d0 = 0; d0 < NKS; ++d0) { const bf16x8 a0 = *(const LAS bf16x8*)(kb + d0 * 2048), a1 = *(const LAS bf16x8*)(kb + d0 * 2048 + 512);
                p0 = MFMA32(a0, qr[d0], p0); p1 = MFMA32(a1, qr[d0], p1); }
            const int qabs = q0w + r32, kv0 = 64 * t + 4 * hi;
            if (MIX == 1) {
                const bool diag = (t == cw);
                float lb0[16], lb1[16], gsum[8];
#pragma unroll
                for (int g = 0; g < 8; ++g) gsum[g] = 0.f;
#pragma unroll
                for (int i = 0; i < 16; ++i) {
                    const int kvA = kv0 + (i & 3) + 8 * (i >> 2);
                    { const float z = p0[i]; const float sp = fmaxf(z, 0.f) + fast_log2(1.0f + fast_exp2(-fabsf(z))); const bool valid = !diag || (kvA < qabs);
                      lb0[i] = valid ? z - sp : -1.0e30f; const float lk = valid ? -sp : 0.f; p0[i] = lk; gsum[i >> 2] += lk; }
                    { const float z = p1[i]; const float sp = fmaxf(z, 0.f) + fast_log2(1.0f + fast_exp2(-fabsf(z))); const bool valid = !diag || (kvA + 32 < qabs);
                      lb1[i] = valid ? z - sp : -1.0e30f; const float lk = valid ? -sp : 0.f; p1[i] = lk; gsum[4 + (i >> 2)] += lk; }
                }
                float Lg[8], Hg[8];
#pragma unroll
                for (int g = 0; g < 8; ++g) { auto rr = __builtin_amdgcn_permlane32_swap(__float_as_uint(gsum[g]), __float_as_uint(gsum[g]), false, false); Lg[g] = __uint_as_float(rr[0]); Hg[g] = __uint_as_float(rr[1]); }
                float suf = arun;
#pragma unroll
                for (int g = 7; g >= 0; --g) {
                    const float ag = suf + (hi == 0 ? Hg[g] : 0.f);
                    float within = 0.f;
#pragma unroll
                    for (int j = 3; j >= 0; --j) {
                        const int i = (g & 3) * 4 + j;
                        if (g < 4) { const float lk = p0[i]; p0[i] = fast_exp2(lb0[i] + ag + within); within += lk; }
                        else { const float lk = p1[i]; p1[i] = fast_exp2(lb1[i] + ag + within); within += lk; }
                    }
                    suf += Lg[g] + Hg[g];
                }
                arun = suf;
                if (__all(arun < -150.0f)) bdone = true;
            } else {
                if (MIX == 0) {
                    if (t == cw) {
#pragma unroll
                        for (int i = 0; i < 16; ++i) { const int kvA = kv0 + (i & 3) + 8 * (i >> 2); if (kvA > qabs) p0[i] = -1.0e30f; if (kvA + 32 > qabs) p1[i] = -1.0e30f; }
                    }
                }
                if (MIX == 3 && (cw - t) < 3) {
#pragma unroll
                    for (int i = 0; i < 16; ++i) { const int kvA = kv0 + (i & 3) + 8 * (i >> 2); int d0i = qabs - kvA; int d1i = d0i - 32;
                        d0i = d0i < -128 ? -128 : (d0i > 128 ? 128 : d0i); d1i = d1i < -128 ? -128 : (d1i > 128 ? 128 : d1i);
                        p0[i] += relL[d0i + 128]; p1[i] += relL[d1i + 128]; }
                }
                float rm = max3f(p0[0], p1[0], p0[1]), rm2 = max3f(p1[1], p0[2], p1[2]);
#pragma unroll
                for (int i = 3; i < 15; i += 2) { rm = max3f(rm, p0[i], p1[i]); rm2 = max3f(rm2, p0[i + 1], p1[i + 1]); }
                rm = max3f(rm, rm2, fmaxf(p0[15], p1[15]));
                rm = swap_max(rm);
                const float mnew = fmaxf(mrun, rm);
                const float f = fast_exp2(mrun - mnew);
                mrun = mnew; lrun *= f;
                float sacc = 0.f;
#pragma unroll
                for (int i = 0; i < 16; ++i) { p0[i] = fast_exp2(p0[i] - mnew); p1[i] = fast_exp2(p1[i] - mnew); sacc += p0[i] + p1[i]; }
                lrun += sacc;
                if (__any(f != 1.0f)) {
                    if (hi == 0) wsf[r32] = f;
                    __builtin_amdgcn_wave_barrier(); asm volatile("s_waitcnt lgkmcnt(0)" ::: "memory");
#pragma unroll
                    for (int i = 0; i < 16; ++i) { const float ff = wsf[crow(i, hi)]; o0[i] *= ff; o1[i] *= ff; }
                    __builtin_amdgcn_wave_barrier();
                }
            }
            v4u pw[4];
#pragma unroll
            for (int s = 0; s < 2; ++s) { pw[s].x = cvt_pk_bf16(p0[8 * s], p0[8 * s + 1]); pw[s].y = cvt_pk_bf16(p0[8 * s + 2], p0[8 * s + 3]); pw[s].z = cvt_pk_bf16(p0[8 * s + 4], p0[8 * s + 5]); pw[s].w = cvt_pk_bf16(p0[8 * s + 6], p0[8 * s + 7]);
                pw[2 + s].x = cvt_pk_bf16(p1[8 * s], p1[8 * s + 1]); pw[2 + s].y = cvt_pk_bf16(p1[8 * s + 2], p1[8 * s + 3]); pw[2 + s].z = cvt_pk_bf16(p1[8 * s + 4], p1[8 * s + 5]); pw[2 + s].w = cvt_pk_bf16(p1[8 * s + 6], p1[8 * s + 7]); }
            const unsigned vp = (unsigned)(size_t)(lds + L_V + slot * VBYTES + ((lane >> 4) & 1) * 32 + (lane & 3) * 8 + (4 * hi + ((lane & 15) >> 2)) * 64);
#define ATT_TR(dst, off) asm volatile("ds_read_b64_tr_b16 %0, %1 offset:%c2" : "=&v"(dst) : "v"(vp), "i"(off) : "memory")
            {
                s16x4 lo[4], hh[4];
#pragma unroll
                for (int ks = 0; ks < 4; ++ks) { ATT_TR(lo[ks], ks * 1024); ATT_TR(hh[ks], ks * 1024 + 512); }
                asm volatile("s_waitcnt lgkmcnt(0)" ::: "memory"); __builtin_amdgcn_sched_barrier(0);
#pragma unroll
                for (int ks = 0; ks < 4; ++ks) { const bf16x8 vf = {lo[ks][0], lo[ks][1], lo[ks][2], lo[ks][3], hh[ks][0], hh[ks][1], hh[ks][2], hh[ks][3]}; o0 = MFMA32(__builtin_bit_cast(bf16x8, pw[ks]), vf, o0); }
#pragma unroll
                for (int ks = 0; ks < 4; ++ks) { ATT_TR(lo[ks], 4096 + ks * 1024); ATT_TR(hh[ks], 4096 + ks * 1024 + 512); }
                asm volatile("s_waitcnt lgkmcnt(0)" ::: "memory"); __builtin_amdgcn_sched_barrier(0);
#pragma unroll
                for (int ks = 0; ks < 4; ++ks) { const bf16x8 vf = {lo[ks][0], lo[ks][1], lo[ks][2], lo[ks][3], hh[ks][0], hh[ks][1], hh[ks][2], hh[ks][3]}; o1 = MFMA32(__builtin_bit_cast(bf16x8, pw[ks]), vf, o1); }
            }
#undef ATT_TR
        }
        if (MIX == 1) { if (lane == 0) doneL[(it & 1) * 8 + wid] = bdone ? 1 : 0; }
        if (more) ATT_WAIT_NEWEST(); else ATT_WAITBAR(0);
        slot = (slot == 2) ? 0 : slot + 1;
        if (MIX == 1) {
            const int fl = (lane < 8) ? doneL[(it & 1) * 8 + lane] : 1;
            if (__all(fl != 0)) { ATT_WAITBAR(0); break; }
        }
    }
    {
        if (MIX != 1) {
            const float lt = swap_sum(lrun);
            if (hi == 0) wsf[r32] = fast_rcp(lt);
            __builtin_amdgcn_wave_barrier(); asm volatile("s_waitcnt lgkmcnt(0)" ::: "memory");
#pragma unroll
            for (int i = 0; i < 16; ++i) { const float ff = wsf[crow(i, hi)]; o0[i] *= ff; o1[i] *= ff; }
        }
        LAS bf16* stg = (LAS bf16*)(lds + L_OST) + wid * 2048;
#pragma unroll
        for (int i = 0; i < 16; ++i) { const int orow = crow(i, hi); const unsigned pk = cvt_pk_bf16(o0[i], o1[i]); stg[orow * 64 + r32] = (bf16)(pk & 0xffffu); stg[orow * 64 + 32 + r32] = (bf16)(pk >> 16); }
        __builtin_amdgcn_wave_barrier(); asm volatile("s_waitcnt lgkmcnt(0)" ::: "memory");
        char* Ow = (char*)(T.O + (size_t)(rowbase + q0w) * 1024);
#pragma unroll
        for (int i = 0; i < 4; ++i) { const int row = i * 8 + (lane >> 3), ch = lane & 7; const v4u v = *(const LAS v4u*)(stg + row * 64 + ch * 8); *(v4u*)(Ow + (unsigned)((row * 1024 + ch * 8) * 2)) = v; }
    }
#undef ATT_ISSUE
#undef ATT_WAITBAR
#undef ATT_WAIT_NEWEST
#undef ATT_TILE
}

DI void attn_phase(const Frame& F, const Args& A, int layer) {
    unsigned char* ws = F.ws;
    const bf16* PROJ = (const bf16*)(ws + WS_PROJ); bf16* O = (bf16*)(ws + WS_O);
    const float* logf = (const float*)(ws + WS_LOGF);
    const float sc8 = 0.125f * LOG2E;
    for (int p = F.bx; p < NBC * 16; p += F.G) {
        const int bh = p >> 2, b = bh >> 2, h = bh & 3, x = p & 3;
        { Tens T{PROJ + PA_Q + 64 * h, PROJ + PA_K + 64 * h, PROJ + PA_V + 64 * h, PS, PS, PS, O + 0 + 64 * h, sc8};
          for (int j = 0; j < 2; ++j) attn_unit<0>(F, T, b, h, j ? 7 - x : x, logf, nullptr); }
        { Tens T{PROJ + PB_Q + 64 * h, PROJ + PB_K + 64 * h, PROJ + PB_V + 64 * h, PS, PS, PS, O + 256 + 64 * h, sc8};
          for (int j = 0; j < 2; ++j) attn_unit<1>(F, T, b, h, j ? 7 - x : x, nullptr, nullptr); }
        { Tens T{(const bf16*)(ws + WS_QC) + 96 * h, (const bf16*)(ws + WS_KC) + 96 * h, (const bf16*)(ws + WS_QKVC) + 384 + 128 * h + 64, 384, 384, 1024, O + 512 + 64 * h, 1.0f};
          for (int j = 0; j < 2; ++j) attn_unit<2>(F, T, b, h, j ? 7 - x : x, nullptr, nullptr); }
        { Tens T{PROJ + PD_Q + 64 * h, PROJ + PD_K + 64 * h, PROJ + PD_V + 64 * h, PS, PS, PS, O + 768 + 64 * h, sc8};
          const float* relb = inp(F, 19) + ((size_t)layer * 4 + h) * 257;
          for (int j = 0; j < 2; ++j) attn_unit<3>(F, T, b, h, j ? 7 - x : x, nullptr, relb); }
    }
    __syncthreads();
}
}
#ifndef MK_MULTI
#define MK_MULTI 0
#endif

using pg8::Unit; using pg8::Acc;
DI void pack8_store(bf16* p, const f32x4 v0, const f32x4 v1) { v4u w; w.x = cvt_pk_bf16(v0[0], v0[1]); w.y = cvt_pk_bf16(v0[2], v0[3]); w.z = cvt_pk_bf16(v1[0], v1[1]); w.w = cvt_pk_bf16(v1[2], v1[3]); *(v4u*)p = w; }
DI f32x4 sig4(const f32x4 v) { return (f32x4){sigmoid_f(v[0]), sigmoid_f(v[1]), sigmoid_f(v[2]), sigmoid_f(v[3])}; }
DI void unpack8(const v4u raw, f32x4& a, f32x4& b) { a = (f32x4){bf_lo(raw.x), bf_hi(raw.x), bf_lo(raw.y), bf_hi(raw.y)}; b = (f32x4){bf_lo(raw.z), bf_hi(raw.z), bf_lo(raw.w), bf_hi(raw.w)}; }

struct EpiStore {
    static constexpr bool PERM = true, CHAIN = false;
    bf16* O; int ldc; int sig_pn; float scale;
    DI void operator()(Acc& acc, const Unit& u, bool, const Unit&, int wr, int wc, int fr, int fq) const {
        const int row0 = u.pm * 256 + wr * 64 + fr, col0 = u.pn * 256 + wc * 32 + 8 * fq;
        const bool sg = u.pn >= sig_pn;
#pragma unroll
        for (int ai = 0; ai < 2; ++ai)
#pragma unroll
            for (int m = 0; m < 4; ++m) { bf16* rowp = O + (size_t)(row0 + ai * 128 + m * 16) * ldc + col0;
#pragma unroll
                for (int bj = 0; bj < 2; ++bj) { f32x4 v0 = acc[ai][bj][m][0], v1 = acc[ai][bj][m][1]; if (sg) { v0 = sig4(v0 * scale); v1 = sig4(v1 * scale); } pack8_store(rowp + bj * 128, v0, v1); } }
    }
};
struct EpiSwiGLU {
    static constexpr bool PERM = true, CHAIN = false;
    bf16* O;
    DI void operator()(Acc& acc, const Unit& u, bool, const Unit&, int wr, int wc, int fr, int fq) const {
        const int row0 = u.pm * 256 + wr * 64 + fr, col0 = u.pn * 128 + wc * 32 + 8 * fq;
#pragma unroll
        for (int ai = 0; ai < 2; ++ai)
#pragma unroll
            for (int m = 0; m < 4; ++m) { bf16* rowp = O + (size_t)(row0 + ai * 128 + m * 16) * 256 + col0;
                const f32x4 g0 = acc[ai][0][m][0], g1 = acc[ai][0][m][1];
                pack8_store(rowp, g0 * sig4(g0) * acc[ai][1][m][0], g1 * sig4(g1) * acc[ai][1][m][1]); }
    }
};
struct EpiGateChain {
    static constexpr bool PERM = true, CHAIN = true;
    const unsigned char* G;
    bf16* O;
    DI void operator()(Acc& acc, const Unit& u, bool, const Unit&, int wr, int wc, int fr, int fq) const {
        const int row0 = u.pm * 256 + wr * 64 + fr, col0 = u.pn * 256 + wc * 32 + 8 * fq, b = u.aux;
        const int wid = wr * 4 + wc, lane = fq * 16 + fr;
        const unsigned char* gt = G + ((size_t)((b * (TC / 256) + u.pm) * 4 + u.pn) * 65536) + (size_t)(wid * 64 + lane) * 8;
#pragma unroll
        for (int ai = 0; ai < 2; ++ai) {
            v2u gc[4][2];
#pragma unroll
            for (int m = 0; m < 4; ++m)
#pragma unroll
                for (int bj = 0; bj < 2; ++bj) gc[m][bj] = *(const v2u*)(gt + (size_t)(((ai * 4 + m) * 2 + bj) * 512) * 8);
#pragma unroll
            for (int m = 0; m < 4; ++m) {
                const size_t r = (size_t)(row0 + ai * 128 + m * 16);
#pragma unroll
                for (int bj = 0; bj < 2; ++bj) {
                    const f32x4 c0 = unpk4_fp8(gc[m][bj].x), c1 = unpk4_fp8(gc[m][bj].y);
                    if (b == 3) { pack8_store(O + r * 1024 + col0 + bj * 128, acc[ai][bj][m][0] * c0, acc[ai][bj][m][1] * c1);
                        acc[ai][bj][m][0] = (f32x4){0.f, 0.f, 0.f, 0.f}; acc[ai][bj][m][1] = (f32x4){0.f, 0.f, 0.f, 0.f}; }
                    else { acc[ai][bj][m][0] = acc[ai][bj][m][0] * c0; acc[ai][bj][m][1] = acc[ai][bj][m][1] * c1; }
                }
            }
            asm volatile("" ::: "memory");
        }
    }
};
struct EpiResGate {
    static constexpr bool PERM = true, CHAIN = false;
    const float* xin32; const bf16* xin16; bf16* xout; const float* modg;
    DI void operator()(Acc& acc, const Unit& u, bool, const Unit&, int wr, int wc, int fr, int fq) const {
        const int col0 = u.pn * 256 + wc * 32 + 8 * fq;
        const float* gv = modg + (size_t)((u.pm * 256) / S) * 6144 + col0;
        f32x4 g[2][2];
#pragma unroll
        for (int bj = 0; bj < 2; ++bj)
#pragma unroll
            for (int n = 0; n < 2; ++n) g[bj][n] = *(const f32x4*)(gv + bj * 128 + n * 4);
        const size_t off0 = (size_t)(u.pm * 256 + wr * 64 + fr) * D + col0;
        if (xin32) {
#pragma unroll
            for (int ai = 0; ai < 2; ++ai)
#pragma unroll
                for (int mp = 0; mp < 4; mp += 2) {
                    f32x4 x[2][2][2];
#pragma unroll
                    for (int mm = 0; mm < 2; ++mm)
#pragma unroll
                        for (int bj = 0; bj < 2; ++bj) { const float* p = xin32 + off0 + (size_t)(ai * 128 + (mp + mm) * 16) * D + bj * 128; x[mm][bj][0] = *(const f32x4*)p; x[mm][bj][1] = *(const f32x4*)(p + 4); }
#pragma unroll
                    for (int mm = 0; mm < 2; ++mm)
#pragma unroll
                        for (int bj = 0; bj < 2; ++bj) pack8_store(xout + off0 + (size_t)(ai * 128 + (mp + mm) * 16) * D + bj * 128, x[mm][bj][0] + g[bj][0] * acc[ai][bj][mp + mm][0], x[mm][bj][1] + g[bj][1] * acc[ai][bj][mp + mm][1]);
                    asm volatile("" ::: "memory"); }
        } else {
#pragma unroll
            for (int ai = 0; ai < 2; ++ai) {
                v4u xr[4][2];
#pragma unroll
                for (int m = 0; m < 4; ++m)
#pragma unroll
                    for (int bj = 0; bj < 2; ++bj) xr[m][bj] = *(const v4u*)(xin16 + off0 + (size_t)(ai * 128 + m * 16) * D + bj * 128);
#pragma unroll
                for (int m = 0; m < 4; ++m)
#pragma unroll
                    for (int bj = 0; bj < 2; ++bj) { f32x4 x0, x1; unpack8(xr[m][bj], x0, x1); pack8_store(xout + off0 + (size_t)(ai * 128 + m * 16) * D + bj * 128, x0 + g[bj][0] * acc[ai][bj][m][0], x1 + g[bj][1] * acc[ai][bj][m][1]); }
                asm volatile("" ::: "memory"); }
        }
    }
};
struct EpiMoeOut {
    static constexpr bool PERM = true, CHAIN = false;
    const bf16* xin; bf16* xout16; float* xout32; const float* modg; const bf16* Y; const int* tokpos; const float* tokw; const LAS int* tb;
    DI void operator()(Acc& acc, const Unit& u, bool, const Unit&, int wr, int wc, int fr, int fq) const {
        const int col0 = u.pn * 256 + wc * 32 + 8 * fq;
        const float* gv = modg + (size_t)((u.pm * 256) / S) * 6144 + col0;
        f32x4 g[2][2];
#pragma unroll
        for (int bj = 0; bj < 2; ++bj)
#pragma unroll
            for (int n = 0; n < 2; ++n) g[bj][n] = *(const f32x4*)(gv + bj * 128 + n * 4);
#pragma unroll
        for (int ai = 0; ai < 2; ++ai)
#pragma unroll
            for (int mp = 0; mp < 4; mp += 2) {
                v4u xr[2][2], ya[2][2], yb[2][2]; float w0[2], w1[2]; size_t off[2];
#pragma unroll
                for (int mm = 0; mm < 2; ++mm) { const int row = u.pm * 256 + ai * 128 + wr * 64 + (mp + mm) * 16 + fr; off[mm] = (size_t)row * D + col0;
                    const int s0 = tokpos[row * 2], s1 = tokpos[row * 2 + 1]; w0[mm] = tokw[row * 2]; w1[mm] = tokw[row * 2 + 1];
                    const int p0 = tb[s0 >> 20] * 256 + (s0 & 0xfffff), p1 = tb[s1 >> 20] * 256 + (s1 & 0xfffff);
                    const bf16* y0 = Y + (size_t)p0 * 1024 + col0; const bf16* y1 = Y + (size_t)p1 * 1024 + col0;
#pragma unroll
                    for (int bj = 0; bj < 2; ++bj) { xr[mm][bj] = *(const v4u*)(xin + off[mm] + bj * 128); ya[mm][bj] = *(const v4u*)(y0 + bj * 128); yb[mm][bj] = *(const v4u*)(y1 + bj * 128); } }
#pragma unroll
                for (int mm = 0; mm < 2; ++mm)
#pragma unroll
                    for (int bj = 0; bj < 2; ++bj) { f32x4 x0, x1, a0, a1, b0, b1; unpack8(xr[mm][bj], x0, x1); unpack8(ya[mm][bj], a0, a1); unpack8(yb[mm][bj], b0, b1);
                        const f32x4 r0 = x0 + g[bj][0] * (acc[ai][bj][mp + mm][0] + a0 * w0[mm] + b0 * w1[mm]), r1 = x1 + g[bj][1] * (acc[ai][bj][mp + mm][1] + a1 * w0[mm] + b1 * w1[mm]);
                        if (xout32) { *(f32x4*)(xout32 + off[mm] + bj * 128) = r0; *(f32x4*)(xout32 + off[mm] + bj * 128 + 4) = r1; } else pack8_store(xout16 + off[mm] + bj * 128, r0, r1); }
                asm volatile("" ::: "memory"); }
    }
};

struct SchedDense {
    int nM, nN, nwg, G, c; const char* A; const char* B; size_t atile, btile;
    DI void init(int nM_, int nN_, int G_, int c_, const void* A_, size_t atile_, const void* B_, size_t btile_) { nM = nM_; nN = nN_; nwg = nM * nN; G = G_; c = c_; A = (const char*)A_; B = (const char*)B_; atile = atile_; btile = btile_; }
    DI bool next(int i, Unit& u) const {
        const long L = (long)i * G + c; if (L >= nwg) return false;
        int wgid = (int)L; { const int q = nwg / 8, r = nwg % 8, xcd = wgid % 8, off = wgid / 8; wgid = (xcd < r ? xcd * (q + 1) : r * (q + 1) + (xcd - r) * q) + off; }
        const int nig = 8 * nN, gid = wgid / nig, fm = gid * 8, gsz = (nM - fm) < 8 ? (nM - fm) : 8;
        u.pm = fm + ((wgid % nig) % gsz); u.pn = (wgid % nig) / gsz; u.aux = 0;
        u.pa = A + (size_t)u.pm * atile; u.pb = B + (size_t)u.pn * btile; return true;
    }
};
struct SchedBranch {
    int ntile, G, c; const char* O; const char* W;
    DI bool next(int i, Unit& u) const {
        const long ti = (long)(i >> 2) * G + c; if (ti >= ntile) return false;
        const int b = i & 3; u.pm = (int)(ti >> 2); u.pn = (int)(ti & 3); u.aux = b;
        u.pa = O + (size_t)u.pm * (256 * 1024 * 2) + b * 512; u.pb = W + (size_t)b * (1024 * 256 * 2) + (size_t)u.pn * (256 * 256 * 2); return true;
    }
};
DI void moe_tables(const Frame& F, int set) {
    LAS int* ne = (LAS int*)(F.lds + MOET_OFF); LAS int* tb = ne + 16;
    __syncthreads();
    if (F.tid < 16) ne[F.tid] = (int)__hip_atomic_load((unsigned*)(F.ws + WS_CTL) + CW_GCNT + 64 * set + F.tid, __ATOMIC_RELAXED, __HIP_MEMORY_SCOPE_AGENT);
    __syncthreads();
    if (F.tid == 0) { int t = 0; for (int e = 0; e < 16; ++e) { tb[e] = t; t += (ne[e] + 255) >> 8; } tb[16] = t; }
    __syncthreads();
}
DI int moe_tile_expert(const LAS int* tb, int m) { int e = 0;
#pragma unroll
    for (int k = 1; k < 16; ++k) e += (m >= tb[k]) ? 1 : 0;
    return e; }
struct SchedMoeUp {
    int G, c; const char* H; const char* W; const LAS int* tb;
    static constexpr int NSH = (TC / 256) * 2;
    DI bool next(int i, Unit& u) const {
        const long L = (long)i * G + c;
        if (L < NSH) { u.pm = (int)(L >> 1); u.pn = (int)(L & 1); u.aux = 16; u.pa = H; u.pb = W + (size_t)16 * (512 * 1024 * 2) + (size_t)u.pn * (256 * 1024 * 2); return true; }
        const int r = (int)(L - NSH), m = r >> 1;
        if (m >= tb[16]) return false;
        const int e = moe_tile_expert(tb, m); u.pm = TC / 256 + m; u.pn = r & 1; u.aux = e;
        u.pa = H; u.pb = W + (size_t)e * (512 * 1024 * 2) + (size_t)u.pn * (256 * 1024 * 2); return true;
    }
};
DI void moe_fill_rows(const Frame& F, const SchedMoeUp& S) {
    LAS int* rows = (LAS int*)(F.lds + ROWS_OFF); const LAS int* ne = (const LAS int*)(F.lds + MOET_OFF); const LAS int* tb = ne + 16;
    const int* LIST = (const int*)(F.ws + WS_LIST);
    for (int i = 0; i < 12; ++i) {
        const long L = (long)i * S.G + S.c;
        if (L < SchedMoeUp::NSH) { if (F.tid < 256) rows[i * 256 + F.tid] = (int)(L >> 1) * 256 + F.tid; continue; }
        const int m = (int)(L - SchedMoeUp::NSH) >> 1; if (m >= tb[16]) break;
        const int e = moe_tile_expert(tb, m), idx = (m - tb[e]) * 256 + F.tid;
        if (F.tid < 256) rows[i * 256 + F.tid] = (idx < ne[e]) ? LIST[e * TC + idx] : 0;
    }
    __syncthreads();
}
struct SchedMoeDn {
    int G, c; const char* HID; const char* W; const LAS int* tb;
    DI bool next(int i, Unit& u) const {
        const long L = (long)i * G + c; const int m = (int)(L >> 2);
        if (m >= tb[16]) return false;
        const int e = moe_tile_expert(tb, m); u.pm = m; u.pn = (int)(L & 3); u.aux = e;
        u.pa = HID + (size_t)(TC + m * 256) * 512; u.pb = W + (size_t)e * (1024 * 256 * 2) + (size_t)u.pn * (256 * 256 * 2); return true;
    }
};

#ifndef ONLY_PH
#define ONLY_PH -1
#endif
#define ONLY_PH_P0 (ONLY_PH < 0 || ONLY_PH == 0)
enum { PH_NORM1 = 1, PH_INPROJ, PH_PREP1, PH_MLAG, PH_PREP2, PH_ATTN, PH_BRANCH, PH_OUT, PH_NORM2, PH_ROUTE, PH_MOEUP, PH_MOEDN, PH_MOEOUT, PH_END };

DI bool launder(Frame& F, unsigned char*& ws, unsigned char* wsa) {
    int w_ = F.wave; asm volatile("" : "+s"(w_));
    int l_ = (int)__builtin_amdgcn_mbcnt_hi(~0u, __builtin_amdgcn_mbcnt_lo(~0u, 0u)); asm volatile("" : "+v"(l_));
    F.lane = l_; F.tid = w_ * 64 + l_;
    asm volatile("" : "+s"(wsa)); ws = wsa; F.ws = wsa; return true; }


#ifndef PROBE_DOUBLE
#define PROBE_DOUBLE 0
#endif
struct Ctx { const float* xin; float* xout; const float* modl; int chunk, layer; };
#define SITE(name) DI void name(Frame& F, const Args& args, unsigned char* ws, const Ctx& C)
SITE(site_norm1) { norm_phase<false>(F, args, C.xin, (const bf16*)(ws + WS_XB), C.chunk, C.layer); }
SITE(site_inproj) {
    {
        SchedDense Sd; Sd.init(TC / 256, PG / 256, F.G, F.bx, ws + WS_H, (size_t)256 * 1024 * 2, ws + WS_WIN + (size_t)C.layer * NP * 1024 * 2, (size_t)256 * 1024 * 2);
        EpiStore E{(bf16*)(ws + WS_PROJ), PS, 1 << 30, 1.0f};
        pg8::gemm_phase(F.lds, F.tid, 1024, 1024, 1024, Sd, E); }
    g8::gate_gemm_fp8(F.lds, F.tid, F.G, F.bx, ws + WS_H8, ws + WS_WIN + ((size_t)C.layer * NP + PG) * 1024 * 2, (unsigned char*)(ws + WS_GT), 1.0f / WG8_SCALE, TC / 256, ((TC / 256) * (PG / 256)) % F.G);
}
SITE(site_prep1) { prep1_phase(F, args, C.chunk, C.layer); }
SITE(site_mlag) {
    SchedDense Sd; Sd.init(TC / 256, 4, F.G, F.bx, ws + WS_PROJ + PC_CQ * 2, (size_t)256 * PS * 2, ws + WS_WMLA + (size_t)C.layer * 1024 * 384 * 2, (size_t)256 * 384 * 2);
    EpiStore E{(bf16*)(ws + WS_QKVC), 1024, 1 << 30, 1.0f};
    pg8::gemm_phase(F.lds, F.tid, PS, 384, 384, Sd, E); }
SITE(site_prep2) { prep2_phase(F, args, C.layer); }
SITE(site_attn) { att::attn_phase(F, args, C.layer); }
SITE(site_branch) {
    SchedBranch Sb{(TC / 256) * 4, F.G, F.bx, (const char*)(ws + WS_O), (const char*)(ws + WS_WBR + (size_t)C.layer * 4 * 1024 * 256 * 2)};
    EpiGateChain E{(const unsigned char*)(ws + WS_GT), (bf16*)(ws + WS_MG)};
    pg8::gemm_phase(F.lds, F.tid, 1024, 256, 256, Sb, E); }
SITE(site_out) {
    SchedDense Sd; Sd.init(TC / 256, 4, F.G, F.bx, ws + WS_MG, (size_t)256 * 1024 * 2, ws + WS_WOUT + (size_t)C.layer * 1024 * 1024 * 2, (size_t)256 * 1024 * 2);
    EpiResGate E{C.xin, (const bf16*)(ws + WS_XB), (bf16*)(ws + WS_XB), C.modl + 2048};
    pg8::gemm_phase(F.lds, F.tid, 1024, 1024, 1024, Sd, E); }
SITE(site_norm2) { norm_phase<true>(F, args, nullptr, (const bf16*)(ws + WS_XB), C.chunk, C.layer); }
SITE(site_moeup) {
    moe_tables(F, C.chunk * NL + C.layer);
    SchedMoeUp Sm{F.G, F.bx, (const char*)(ws + WS_H), (const char*)(ws + WS_WGU + (size_t)C.layer * NEXP1 * 512 * 1024 * 2), (const LAS int*)(F.lds + MOET_OFF) + 16};
    moe_fill_rows(F, Sm);
    EpiSwiGLU E{(bf16*)(ws + WS_HID)};
    pg8::gemm_phase<EpiSwiGLU, SchedMoeUp, true>(F.lds, F.tid, 1024, 1024, 1024, Sm, E, (const LAS int*)(F.lds + ROWS_OFF)); }
SITE(site_moedn) {
    moe_tables(F, C.chunk * NL + C.layer);
    SchedMoeDn Sm{F.G, F.bx, (const char*)(ws + WS_HID), (const char*)(ws + WS_WD + (size_t)C.layer * NEXP1 * 1024 * 256 * 2), (const LAS int*)(F.lds + MOET_OFF) + 16};
    EpiStore E{(bf16*)(ws + WS_YBUF), 1024, 1 << 30, 1.0f};
    pg8::gemm_phase(F.lds, F.tid, 256, 256, 256, Sm, E); }
SITE(site_moeout) {
    moe_tables(F, C.chunk * NL + C.layer);
    SchedDense Sd; Sd.init(TC / 256, 4, F.G, F.bx, ws + WS_HID, (size_t)256 * 256 * 2, ws + WS_WD + ((size_t)C.layer * NEXP1 + 16) * 1024 * 256 * 2, (size_t)256 * 256 * 2);
    EpiMoeOut E{(const bf16*)(ws + WS_XB), (bf16*)(ws + WS_XB), (C.layer == NL - 1) ? C.xout : nullptr, C.modl + 5120, (const bf16*)(ws + WS_YBUF), (const int*)(ws + WS_TOKPOS), (const float*)(ws + WS_TOKW), (const LAS int*)(F.lds + MOET_OFF) + 16};
    pg8::gemm_phase(F.lds, F.tid, 256, 256, 256, Sd, E); }

template <int DUMMY>
DI void layer_body(Frame& F, const Args& args, unsigned char*& ws, const XcdBarrier& bar, const int chunk, const int layer) {
#define GRID_BAR() do { if (args.one) xcd_barrier(bar); } while (0)
#define IN(k) ((ONLY_PH < 0 || ONLY_PH == (k)) && args.ph_lo <= (k) && (k) < args.ph_hi && launder(F, ws, args.ws))
#define RUN(k, fn) do { if (IN(k)) { fn(F, args, ws, C); GRID_BAR(); } if (((PROBE_DOUBLE >> (k)) & 1) && IN(k)) { fn(F, args, ws, C); GRID_BAR(); } } while (0)
    Ctx C; C.chunk = chunk; C.layer = layer;
    C.xout = args.out + (size_t)chunk * TC * D;
    C.xin = (layer == 0) ? inp(F, 0) + (size_t)chunk * TC * D : nullptr;
    C.modl = (const float*)(args.ws + WS_MOD) + ((size_t)layer * NB + chunk * NBC) * 6144;
    RUN(PH_NORM1, site_norm1); RUN(PH_INPROJ, site_inproj); RUN(PH_PREP1, site_prep1); RUN(PH_MLAG, site_mlag); RUN(PH_PREP2, site_prep2); RUN(PH_ATTN, site_attn);
    RUN(PH_BRANCH, site_branch); RUN(PH_OUT, site_out); RUN(PH_NORM2, site_norm2); RUN(PH_MOEUP, site_moeup); RUN(PH_MOEDN, site_moedn); RUN(PH_MOEOUT, site_moeout);
#undef RUN
#undef IN
#undef GRID_BAR
}
__global__ void __launch_bounds__(NTHREADS, 2) trunk_fwd(Args args) {
    extern __shared__ __attribute__((aligned(16))) unsigned char lds_raw[];
    Frame F;
    F.lds = (LAS unsigned char*)lds_raw;
    F.tid = threadIdx.x; F.lane = F.tid & 63; F.wave = __builtin_amdgcn_readfirstlane(F.tid >> 6);
    F.G = gridDim.x; F.bx = blockIdx.x; F.ws = args.ws;
    unsigned char* ws = args.ws;
    gu32* ctl = (gu32*)(ws + WS_CTL);
    volatile LAS unsigned* MISC = (volatile LAS unsigned*)(F.lds + MISC_OFF);
    for (int u = F.tid; u < (LDS_BYTES - RING_BYTES) / 4; u += NTHREADS) ((LAS unsigned*)(F.lds + RING_BYTES))[u] = 0u;
    __syncthreads();
    if (F.tid == 0) {
#pragma unroll
        for (int k = 0; k < 30; ++k) ((volatile LAS unsigned long long*)(F.lds + PTAB_OFF))[k] = (unsigned long long)args.in[k];
    }
    __syncthreads();
    XcdBarrier bar; bar.bar = (unsigned*)(ctl + CW_BAR); bar.x = 0; bar.st = nullptr;
    if (args.one) bar = xcd_barrier_post((unsigned*)(ctl + CW_BAR), MISC + 8);
    if (args.one && F.tid == 0) { const unsigned xcc = xb_xcc_id(); MISC[17] = xcc; MISC[16] = __hip_atomic_fetch_add((unsigned*)(ctl + CW_XRANK) + 64 * xcc, 1u, __ATOMIC_RELAXED, __HIP_MEMORY_SCOPE_AGENT); }
#define GRID_BAR() do { if (args.one) xcd_barrier(bar); } while (0)

    if ((ONLY_PH_P0) && args.ph_lo <= 0) { p0_prologue(F, args); GRID_BAR(); }
    if ((PROBE_DOUBLE & 1) && args.ph_lo <= 0) { launder(F, ws, args.ws); p0_prologue(F, args); GRID_BAR(); }
    if (args.one) {
        if (F.tid == 0) { bool ok = (F.G % 8 == 0) && MISC[17] < 8u;
            for (int j = 0; j < 8; ++j) ok = ok && (__hip_atomic_load((unsigned*)(ctl + CW_XRANK) + 64 * j, __ATOMIC_RELAXED, __HIP_MEMORY_SCOPE_AGENT) == (unsigned)(F.G / 8));
            MISC[18] = ok ? (MISC[16] * 8u + MISC[17]) : (unsigned)blockIdx.x; }
        __syncthreads();
        F.bx = __builtin_amdgcn_readfirstlane((int)MISC[18]);
    }

#if MK_MULTI
    layer_body<0>(F, args, ws, bar, args.c_lo, args.l_lo);
#else
    layer_body<0>(F, args, ws, bar, 0, 0); layer_body<1>(F, args, ws, bar, 0, 1); layer_body<2>(F, args, ws, bar, 0, 2); layer_body<3>(F, args, ws, bar, 0, 3);
    layer_body<4>(F, args, ws, bar, 1, 0); layer_body<5>(F, args, ws, bar, 1, 1); layer_body<6>(F, args, ws, bar, 1, 2); layer_body<7>(F, args, ws, bar, 1, 3);
#endif
}

extern "C" void kernel_launch(void* const* d_in, const int* in_sizes, int n_in, void* d_out, int out_size, void* d_ws, size_t ws_size, hipStream_t stream) {
    static int grid = 0;
    if (grid == 0) {
        if (n_in != 30 || in_sizes[0] != NB * S * D || out_size != NB * S * D || ws_size < WS_END) { fprintf(stderr, "kernel_launch: unexpected shapes / workspace (n_in %d, ws %zu)\n", n_in, ws_size); grid = -1; return; }
        int dev = 0, cus = 0, per_cu = 0;
        if (hipGetDevice(&dev) != hipSuccess || hipDeviceGetAttribute(&cus, hipDeviceAttributeMultiprocessorCount, dev) != hipSuccess) { grid = -1; return; }
        if (hipFuncSetAttribute((const void*)trunk_fwd, hipFuncAttributeMaxDynamicSharedMemorySize, LDS_BYTES) != hipSuccess) { fprintf(stderr, "kernel_launch: hipFuncSetAttribute failed\n"); grid = -1; return; }
        if (hipOccupancyMaxActiveBlocksPerMultiprocessor(&per_cu, (const void*)trunk_fwd, NTHREADS, LDS_BYTES) != hipSuccess || per_cu < 1) fprintf(stderr, "kernel_launch: occupancy query reports %d\n", per_cu);
        (void)hipGetLastError();
        grid = cus;
    }
    if (grid < 0) return;
    (void)hipMemsetAsync((char*)d_ws + WS_CTL, 0, CTL_ZERO_BYTES, stream);
    Args a{};
    for (int i = 0; i < 30; ++i) a.in[i] = (const float*)d_in[i];
    a.out = (float*)d_out; a.ws = (unsigned char*)d_ws;
#if MK_MULTI
    a.one = 0;
    a.c_lo = 0; a.c_hi = 0; a.l_lo = 0; a.l_hi = 0; a.ph_lo = 0; a.ph_hi = 1;
    hipLaunchKernelGGL(trunk_fwd, dim3(grid), dim3(NTHREADS), LDS_BYTES, stream, a);
    for (int c = 0; c < NCHUNK; ++c) for (int l = 0; l < NL; ++l) for (int ph = 1; ph < PH_END; ++ph) {
        a.c_lo = c; a.c_hi = c + 1; a.l_lo = l; a.l_hi = l + 1; a.ph_lo = ph; a.ph_hi = ph + 1;
        hipLaunchKernelGGL(trunk_fwd, dim3(grid), dim3(NTHREADS), LDS_BYTES, stream, a);
    }
#else
    a.one = 1; a.c_lo = 0; a.c_hi = NCHUNK; a.l_lo = 0; a.l_hi = NL; a.ph_lo = 0; a.ph_hi = PH_END;
    hipLaunchKernelGGL(trunk_fwd, dim3(grid), dim3(NTHREADS), LDS_BYTES, stream, a);
#endif
}
```
